# Optimizing an MI355X kernel written in HIP

```python
import jax, jax.numpy as jnp
from jax import lax
import numpy as np

D_MODEL = 2048
BATCH = 4
SEQ = 2048
DEPTH = 4

GRID_W = 64
N_HEADS = 64
HEAD_DIM = D_MODEL // N_HEADS
WIN_H = 8
WIN_W = 16
POOL_WINDOWS = (2, 4, 8, 16)
N_GROUPS = len(POOL_WINDOWS)
GROUP_CH = D_MODEL // N_GROUPS
D_FF = ((8 * D_MODEL + 3 * 256 - 1) // (3 * 256)) * 256
PLE_DIM = 256
N_MIXERS = 2
N_ATTN = (DEPTH + 1) // 2
N_POOL = DEPTH // 2
RMS_EPS = 1e-6

kernel_name = "hybrid_natten_poolformer_encoder"


def rms_norm(x, g):
    xf = x.astype(jnp.float32)
    y = xf * lax.rsqrt(jnp.mean(xf * xf, axis=-1, keepdims=True) + RMS_EPS)
    return (y * g.astype(jnp.float32)).astype(x.dtype)


def neighbourhood_attention(h, w_qkv, b_qkv, w_o, rpb):
    B, S, _ = h.shape
    rows = S // GRID_W
    kh = min(WIN_H, rows)
    qkv = (h @ w_qkv + b_qkv).reshape(B, S, 3, N_HEADS, HEAD_DIM)
    q = qkv[:, :, 0] * (HEAD_DIM ** -0.5)
    k = qkv[:, :, 1]
    v = qkv[:, :, 2]

    qc = jnp.arange(GRID_W)[:, None]
    kc = jnp.arange(GRID_W)[None, :]
    c_start = jnp.clip(qc - WIN_W // 2, 0, GRID_W - WIN_W)
    col_mask = (kc >= c_start) & (kc < c_start + WIN_W)
    dc_idx = jnp.clip(kc - qc, -(WIN_W - 1), WIN_W - 1) + (WIN_W - 1)
    mask = jnp.broadcast_to(col_mask[:, None, :], (GRID_W, kh, GRID_W)).reshape(GRID_W, kh * GRID_W)
    neg = jnp.finfo(jnp.float32).min

    def row_block(r):
        r_start = jnp.clip(r - kh // 2, 0, rows - kh)
        qb = lax.dynamic_slice_in_dim(q, r * GRID_W, GRID_W, axis=1)
        kb = lax.dynamic_slice_in_dim(k, r_start * GRID_W, kh * GRID_W, axis=1)
        vb = lax.dynamic_slice_in_dim(v, r_start * GRID_W, kh * GRID_W, axis=1)
        dr_idx = r_start + jnp.arange(kh) - r + (WIN_H - 1)
        bias = rpb[:, dr_idx[None, :, None], dc_idx[:, None, :]]
        bias = bias.reshape(N_HEADS, GRID_W, kh * GRID_W).astype(jnp.float32)
        s = jnp.einsum('bqhd,bkhd->bhqk', qb, kb).astype(jnp.float32) + bias[None]
        s = jnp.where(mask[None, None], s, neg)
        pr = jax.nn.softmax(s, axis=-1).astype(vb.dtype)
        return jnp.einsum('bhqk,bkhd->bqhd', pr, vb)

    o = lax.map(row_block, jnp.arange(rows))
    o = jnp.transpose(o, (1, 0, 2, 3, 4)).reshape(B, S, N_HEADS * HEAD_DIM)
    return o @ w_o


def multiscale_pool(h, w_pool, scale):
    B, S, D = h.shape
    hf = h.astype(jnp.float32)
    csum = jnp.concatenate([jnp.zeros((B, 1, D), jnp.float32), lax.cumsum(hf, axis=1)], axis=1)
    csum = csum.reshape(B, S + 1, N_GROUPS, GROUP_CH)
    t = jnp.arange(S)
    means = []
    for g, w in enumerate(POOL_WINDOWS):
        lo = jnp.clip(t - w // 2, 0, S)
        hi = jnp.clip(t + w - w // 2, 0, S)
        cnt = (hi - lo).astype(jnp.float32)
        cg = csum[:, :, g]
        seg = jnp.take(cg, hi, axis=1) - jnp.take(cg, lo, axis=1)
        means.append(seg / cnt[None, :, None])
    pooled = jnp.stack(means, axis=2)
    mixed = (pooled - hf.reshape(B, S, N_GROUPS, GROUP_CH)).astype(h.dtype)
    out = jnp.einsum('bsgc,gce->bsge', mixed, w_pool).reshape(B, S, D)
    return out * scale


def swiglu(h, w_gate, w_up, w_down):
    return (jax.nn.silu(h @ w_gate) * (h @ w_up)) @ w_down


def setup_inputs(seed: int = 0) -> dict:
    key = jax.random.key(seed)
    ks = jax.random.split(key, 24)
    f32 = jnp.float32
    nrm = lambda k, shape, s: jax.random.normal(k, shape, f32) * s
    gain = lambda k, shape: 1.0 + 0.01 * jax.random.normal(k, shape, f32)
    return {
        "x": nrm(ks[0], (BATCH, SEQ, D_MODEL), 1.0),
        "p": nrm(ks[1], (DEPTH, BATCH, SEQ, PLE_DIM), 1.0),
        "attn_norm_g": gain(ks[2], (N_ATTN, D_MODEL)),
        "w_qkv": nrm(ks[3], (N_ATTN, D_MODEL, 3 * D_MODEL), D_MODEL ** -0.5),
        "b_qkv": nrm(ks[4], (N_ATTN, 3 * D_MODEL), 0.01),
        "w_o": nrm(ks[5], (N_ATTN, D_MODEL, D_MODEL), D_MODEL ** -0.5),
        "rpb": nrm(ks[6], (N_ATTN, N_HEADS, 2 * WIN_H - 1, 2 * WIN_W - 1), 0.1),
        "pool_norm_g": gain(ks[7], (N_POOL, D_MODEL)),
        "w_pool": nrm(ks[8], (N_POOL, N_GROUPS, GROUP_CH, GROUP_CH), GROUP_CH ** -0.5),
        "pool_scale": 1.0 + 0.1 * jax.random.normal(ks[9], (N_POOL, D_MODEL), f32),
        "ffn_norm_g": gain(ks[10], (DEPTH, D_MODEL)),
        "w_gate": nrm(ks[11], (DEPTH, D_MODEL, D_FF), D_MODEL ** -0.5),
        "w_up": nrm(ks[12], (DEPTH, D_MODEL, D_FF), D_MODEL ** -0.5),
        "w_down": nrm(ks[13], (DEPTH, D_FF, D_MODEL), D_FF ** -0.5),
        "ple_norm_g": gain(ks[14], (DEPTH, D_MODEL)),
        "w_ple_gate": nrm(ks[15], (DEPTH, D_MODEL, D_MODEL), D_MODEL ** -0.5),
        "b_ple_gate": nrm(ks[16], (DEPTH, D_MODEL), 0.01),
        "w_ple_proj": nrm(ks[17], (DEPTH, PLE_DIM, D_MODEL), PLE_DIM ** -0.5),
        "final_norm_g": gain(ks[18], (D_MODEL,)),
    }


def reference(x, p, attn_norm_g, w_qkv, b_qkv, w_o, rpb, pool_norm_g, w_pool, pool_scale,
              ffn_norm_g, w_gate, w_up, w_down, ple_norm_g, w_ple_gate, b_ple_gate,
              w_ple_proj, final_norm_g):
    for i in range(DEPTH):
        j = i // N_MIXERS
        if i % N_MIXERS == 0:
            x = x + neighbourhood_attention(rms_norm(x, attn_norm_g[j]), w_qkv[j], b_qkv[j], w_o[j], rpb[j])
        else:
            x = x + multiscale_pool(rms_norm(x, pool_norm_g[j]), w_pool[j], pool_scale[j])
        x = x + swiglu(rms_norm(x, ffn_norm_g[i]), w_gate[i], w_up[i], w_down[i])
        gate = jax.nn.sigmoid(rms_norm(x, ple_norm_g[i]) @ w_ple_gate[i] + b_ple_gate[i])
        x = x + (p[i] @ w_ple_proj[i]) * gate
    return rms_norm(x, final_norm_g)
```

```cpp
#include <hip/hip_runtime.h>
#include <hip/hip_cooperative_groups.h>
#include <cstdio>
#include <cstdint>
namespace cg = cooperative_groups;

#define LAS __attribute__((address_space(3)))
typedef unsigned short bf16_t;
typedef short bf16x8 __attribute__((ext_vector_type(8)));
typedef float f32x4 __attribute__((ext_vector_type(4)));
typedef unsigned u32x4 __attribute__((ext_vector_type(4)));
typedef unsigned u32x2 __attribute__((ext_vector_type(2)));

constexpr int D = 2048, NTOK = 8192, SEQ = 2048, DFF = 5632, PLE = 256, NH = 64, HD = 32, DEPTH = 4;
constexpr float RMS_EPS = 1e-6f;
constexpr float LOG2E = 1.4426950408889634f;
constexpr float QSCALE = 0.17677669529663687f * LOG2E;

constexpr size_t MiB = 1u << 20;
constexpr size_t WS_WQK = 0;
constexpr size_t WS_WV = WS_WQK + 32 * MiB;
constexpr size_t WS_WO = WS_WV + 16 * MiB;
constexpr size_t WS_WPOOL = WS_WO + 16 * MiB;
constexpr size_t WS_WGU = WS_WPOOL + 4 * MiB;
constexpr size_t WS_WD = WS_WGU + 176 * MiB;
constexpr size_t WS_WPG = WS_WD + 88 * MiB;
constexpr size_t WS_WPP = WS_WPG + 32 * MiB;
constexpr size_t WS_PB = WS_WPP + 4 * MiB;
constexpr size_t WS_H = WS_PB + 16 * MiB;
constexpr size_t WS_QK = WS_H + 32 * MiB;
constexpr size_t WS_VT = WS_QK + 64 * MiB;
constexpr size_t WS_O = WS_VT + 32 * MiB;
constexpr size_t WS_PP = WS_O + 32 * MiB;
constexpr size_t WS_SSQ = WS_PP + 32 * MiB;
constexpr size_t WS_H2 = WS_SSQ + 1 * MiB;
constexpr size_t WS_BAR = WS_H2 + 32 * MiB;
constexpr size_t WS_ACT = WS_BAR + 1 * MiB;
constexpr size_t WS_END = WS_ACT + 88 * MiB;

constexpr int NWAVES = 8;
constexpr int LDS_BYTES = 147456;

__device__ __forceinline__ int tid_now(int wave_s) { int l; asm volatile("v_mbcnt_lo_u32_b32 %0, -1, 0\n\tv_mbcnt_hi_u32_b32 %0, -1, %0" : "=v"(l)); return wave_s * 64 + l; }

namespace pg8 {
constexpr int BM = 256, BK = 64, HALF = 128, HTB = HALF * BK * 2, NXCD = 8, WGM = 8;

__host__ __device__ __forceinline__ int lds_byte(int r, int c) { const int st = (r >> 4) * 2 + (c >> 5), rr = r & 15, cc = c & 31, ob = rr * 64 + cc * 2; return st * 1024 + (ob ^ (((ob >> 9) & 1) << 5)); }
__host__ __device__ __forceinline__ void stage_rc(int b, int& R, int& C) { const int st = b / 1024, sb = b % 1024, swz = sb ^ (((sb >> 9) & 1) << 5); R = (st >> 1) * 16 + swz / 64; C = (st & 1) * 32 + (swz % 64) / 2; }
__host__ __device__ __forceinline__ int perm32(int rho) { const int n = rho >> 4, i = rho & 15; return 8 * (i >> 2) + 4 * n + (i & 3); }

struct Unit { int pm, pn; };
struct Gemm { const bf16_t* A; const bf16_t* Bt; int M, N, K, lda, agrp_shift, agrp_cols; };

struct StaticOrder {
    int nM, nN, nwg, G, c;
    __device__ void init(int M, int N, int G_, int c_) { asm volatile("" : "+s"(c_)); nM = M / BM; nN = N / BM; nwg = nM * nN; G = G_; c = c_; }
    __device__ bool next(int i, Unit& u) const {
        if (c < 0) return false;
        const long L = (long)i * G + c; if (L >= nwg) return false;
        int wgid = (int)L; { const int q = nwg / NXCD, r = nwg % NXCD, xcd = wgid % NXCD, off = wgid / NXCD; wgid = (xcd < r ? xcd * (q + 1) : r * (q + 1) + (xcd - r) * q) + off; }
        const int nig = WGM * nN, gid = wgid / nig, fm = gid * WGM, gsz = (nM - fm) < WGM ? (nM - fm) : WGM;
        u.pm = fm + ((wgid % nig) % gsz); u.pn = (wgid % nig) / gsz; return true;
    }
};

struct GroupOrder {
    int nwg, G, c, p0, mode;
    __device__ void init(int mode_, int nOther, int G_, int c_, int grp) { asm volatile("" : "+s"(c_)); mode = mode_; nwg = 4 * nOther; G = G_; c = c_; p0 = 4 * grp; }
    __device__ bool next(int i, Unit& u) const {
        if (c < 0) return false;
        const int L = i * G + c; if (L >= nwg) return false;
        if (mode == 0) { u.pm = p0 + (L & 3); u.pn = L >> 2; } else { u.pm = L & 7; u.pn = p0 + (L >> 3); }
        return true;
    }
};

__device__ __forceinline__ unsigned cvt_pk_bf16(float lo, float hi) { unsigned r; asm("v_cvt_pk_bf16_f32 %0, %1, %2" : "=v"(r) : "v"(lo), "v"(hi)); return r; }
__device__ __forceinline__ float bf_lo(unsigned w) { return __builtin_bit_cast(float, w << 16); }
__device__ __forceinline__ float bf_hi(unsigned w) { return __builtin_bit_cast(float, w & 0xffff0000u); }
typedef _Float16 h16x2 __attribute__((ext_vector_type(2)));
typedef _Float16 h16x8 __attribute__((ext_vector_type(8)));
__device__ __forceinline__ unsigned cvt_pk_f16(float lo, float hi) { const h16x2 v = {(_Float16)lo, (_Float16)hi}; return __builtin_bit_cast(unsigned, v); }
__device__ __forceinline__ float h_lo(unsigned w) { return (float)__builtin_bit_cast(_Float16, (unsigned short)(w & 0xffffu)); }
__device__ __forceinline__ float h_hi(unsigned w) { return (float)__builtin_bit_cast(_Float16, (unsigned short)(w >> 16)); }

typedef f32x4 Acc[2][2][4][2];

__device__ __forceinline__ float rms_r(float ssq) { return 1.f / sqrtf(ssq * (1.f / D) + RMS_EPS); }
__device__ __forceinline__ void ssq_add(float* p, float v) { __hip_atomic_fetch_add(p, v, __ATOMIC_RELAXED, __HIP_MEMORY_SCOPE_AGENT); }

struct EpiBf16 {
    bf16_t* O; int ldc; const float* bias; const float* ssq; int nscale_tiles; float bscale;
    __device__ __forceinline__ void operator()(const Acc& acc, const Unit& u, int wr, int wc, int fr, int fq) const {
        const int row0 = u.pm * BM + wr * 64 + fr, col0 = u.pn * BM + wc * 32 + 8 * fq;
        const float bs = (u.pn < nscale_tiles) ? bscale : 1.f;
        f32x4 bv[2][2];
#pragma unroll
        for (int bj = 0; bj < 2; ++bj)
#pragma unroll
            for (int n = 0; n < 2; ++n) bv[bj][n] = bias ? *(const f32x4*)(bias + col0 + bj * HALF + 4 * n) * bs : (f32x4){0.f, 0.f, 0.f, 0.f};
        float rrv[8];
#pragma unroll
        for (int q = 0; q < 8; ++q) rrv[q] = ssq ? ssq[row0 + (q >> 2) * HALF + (q & 3) * 16] : 0.f;
#pragma unroll
        for (int ai = 0; ai < 2; ++ai)
#pragma unroll
            for (int m = 0; m < 4; ++m) {
                const int row = row0 + ai * HALF + m * 16;
                const float rr = ssq ? rms_r(rrv[ai * 4 + m]) : 1.f;
                bf16_t* rowp = O + (size_t)row * ldc + col0;
#pragma unroll
                for (int bj = 0; bj < 2; ++bj) {
                    const f32x4 v0 = acc[ai][bj][m][0] * rr + bv[bj][0], v1 = acc[ai][bj][m][1] * rr + bv[bj][1];
                    u32x4 w; w.x = cvt_pk_bf16(v0[0], v0[1]); w.y = cvt_pk_bf16(v0[2], v0[3]); w.z = cvt_pk_bf16(v1[0], v1[1]); w.w = cvt_pk_bf16(v1[2], v1[3]);
                    *(u32x4*)(rowp + bj * HALF) = w;
                }
            }
    }
};

struct EpiVT {
    bf16_t* O; const float* bias; const float* ssq;
    __device__ __forceinline__ void operator()(const Acc& acc, const Unit& u, int wr, int wc, int fr, int fq) const {
        const int row0 = u.pm * BM + wr * 64 + fr, col0 = u.pn * BM + wc * 32 + 8 * fq;
        f32x4 rv[2][2];
#pragma unroll
        for (int bj = 0; bj < 2; ++bj)
#pragma unroll
            for (int n = 0; n < 2; ++n) { const f32x4 s = *(const f32x4*)(ssq + col0 + bj * HALF + 4 * n); rv[bj][n] = (f32x4){rms_r(s[0]), rms_r(s[1]), rms_r(s[2]), rms_r(s[3])}; }
        float brv[8];
#pragma unroll
        for (int q = 0; q < 8; ++q) brv[q] = bias[row0 + (q >> 2) * HALF + (q & 3) * 16];
#pragma unroll
        for (int ai = 0; ai < 2; ++ai)
#pragma unroll
            for (int m = 0; m < 4; ++m) {
                const int row = row0 + ai * HALF + m * 16;
                const float br = brv[ai * 4 + m];
                bf16_t* rowp = O + (size_t)row * NTOK + col0;
#pragma unroll
                for (int bj = 0; bj < 2; ++bj) {
                    const f32x4 v0 = acc[ai][bj][m][0] * rv[bj][0] + br, v1 = acc[ai][bj][m][1] * rv[bj][1] + br;
                    u32x4 w; w.x = cvt_pk_bf16(v0[0], v0[1]); w.y = cvt_pk_bf16(v0[2], v0[3]); w.z = cvt_pk_bf16(v1[0], v1[1]); w.w = cvt_pk_bf16(v1[2], v1[3]);
                    *(u32x4*)(rowp + bj * HALF) = w;
                }
            }
    }
};

struct EpiResid {
    bf16_t* x16; float* ssq_out;
    __device__ __forceinline__ void operator()(Acc& acc, const Unit& u, int wr, int wc, int fr, int fq) const {
        const int row0 = u.pm * BM + wr * 64 + fr, col0 = u.pn * BM + wc * 32 + 8 * fq;
        const size_t base = (size_t)row0 * D + col0;
        u32x4 xv[4][2];
        float ssv[8];
#define ER_LOAD(ai) _Pragma("unroll") for (int m = 0; m < 4; ++m) _Pragma("unroll") for (int bj = 0; bj < 2; ++bj) xv[m][bj] = *(const u32x4*)(x16 + base + (size_t)((ai) * HALF + m * 16) * D + bj * HALF);
#define ER_ADD(ai) _Pragma("unroll") for (int m = 0; m < 4; ++m) _Pragma("unroll") for (int bj = 0; bj < 2; ++bj) { const u32x4 w = xv[m][bj]; \
            acc[ai][bj][m][0] += (f32x4){h_lo(w.x), h_hi(w.x), h_lo(w.y), h_hi(w.y)}; acc[ai][bj][m][1] += (f32x4){h_lo(w.z), h_hi(w.z), h_lo(w.w), h_hi(w.w)}; }
#define ER_STORE(ai) _Pragma("unroll") for (int m = 0; m < 4; ++m) { float ss = 0.f; _Pragma("unroll") for (int bj = 0; bj < 2; ++bj) { \
            const f32x4 x0 = acc[ai][bj][m][0], x1 = acc[ai][bj][m][1]; \
            u32x4 w; w.x = cvt_pk_f16(x0[0], x0[1]); w.y = cvt_pk_f16(x0[2], x0[3]); w.z = cvt_pk_f16(x1[0], x1[1]); w.w = cvt_pk_f16(x1[2], x1[3]); \
            *(u32x4*)(x16 + base + (size_t)((ai) * HALF + m * 16) * D + bj * HALF) = w; \
            ss += (x0[0] * x0[0] + x0[1] * x0[1]) + (x0[2] * x0[2] + x0[3] * x0[3]) + (x1[0] * x1[0] + x1[1] * x1[1]) + (x1[2] * x1[2] + x1[3] * x1[3]); } \
            ssv[(ai) * 4 + m] = ss; }
        ER_LOAD(0); ER_ADD(0); ER_LOAD(1); ER_STORE(0); ER_ADD(1); ER_STORE(1);
#undef ER_LOAD
#undef ER_ADD
#undef ER_STORE
#pragma unroll
        for (int q = 0; q < 8; ++q) { ssv[q] += __shfl_xor(ssv[q], 16); }
#pragma unroll
        for (int q = 0; q < 8; ++q) { ssv[q] += __shfl_xor(ssv[q], 32); }
        if (fq == 0) {
#pragma unroll
            for (int q = 0; q < 8; ++q) ssq_add(ssq_out + row0 + (q >> 2) * HALF + (q & 3) * 16, ssv[q]);
        }
    }
};

struct EpiGU {
    bf16_t* O; const float* ssq;
    __device__ __forceinline__ void operator()(const Acc& acc, const Unit& u, int wr, int wc, int fr, int fq) const {
        const int row0 = u.pm * BM + wr * 64 + fr, col0 = u.pn * HALF + wc * 32 + 8 * fq;
        float rrv[8];
#pragma unroll
        for (int q = 0; q < 8; ++q) rrv[q] = ssq[row0 + (q >> 2) * HALF + (q & 3) * 16];
#pragma unroll
        for (int ai = 0; ai < 2; ++ai)
#pragma unroll
            for (int m = 0; m < 4; ++m) {
                const int row = row0 + ai * HALF + m * 16;
                const float rr = rms_r(rrv[ai * 4 + m]);
                float r[8];
#pragma unroll
                for (int n = 0; n < 2; ++n)
#pragma unroll
                    for (int j = 0; j < 4; ++j) {
                        const float g = acc[ai][0][m][n][j] * rr, up = acc[ai][1][m][n][j] * rr;
                        r[n * 4 + j] = g * __builtin_amdgcn_rcpf(1.f + __builtin_amdgcn_exp2f(-g * LOG2E)) * up;
                    }
                u32x4 w; w.x = cvt_pk_bf16(r[0], r[1]); w.y = cvt_pk_bf16(r[2], r[3]); w.z = cvt_pk_bf16(r[4], r[5]); w.w = cvt_pk_bf16(r[6], r[7]);
                *(u32x4*)(O + (size_t)row * DFF + col0) = w;
            }
    }
};

struct EpiPle {
    const bf16_t* xin16; bf16_t* xout16; const bf16_t* pp; const float* bias; const float* ssq_in; float* ssq_out;
    __device__ __forceinline__ void operator()(Acc& acc, const Unit& u, int wr, int wc, int fr, int fq) const {
        const int row0 = u.pm * BM + wr * 64 + fr, col0 = u.pn * BM + wc * 32 + 8 * fq;
        const size_t base = (size_t)row0 * D + col0;
        f32x4 bv[2][2];
#pragma unroll
        for (int bj = 0; bj < 2; ++bj)
#pragma unroll
            for (int n = 0; n < 2; ++n) bv[bj][n] = *(const f32x4*)(bias + col0 + bj * HALF + 4 * n);
        float rrv[8], ssv[8];
#pragma unroll
        for (int q = 0; q < 8; ++q) rrv[q] = ssq_in[row0 + (q >> 2) * HALF + (q & 3) * 16];
        u32x4 xv[2][2], pv[2][2];
#define EP_LOAD(ai, mp) _Pragma("unroll") for (int mm = 0; mm < 2; ++mm) _Pragma("unroll") for (int bj = 0; bj < 2; ++bj) { const size_t off = base + (size_t)((ai) * HALF + (2 * (mp) + mm) * 16) * D + bj * HALF; \
            xv[mm][bj] = *(const u32x4*)(xin16 + off); pv[mm][bj] = *(const u32x4*)(pp + off); }
#define EP_ADD(ai, mp) _Pragma("unroll") for (int mm = 0; mm < 2; ++mm) { const int m = 2 * (mp) + mm; const float rr = rms_r(rrv[(ai) * 4 + m]); _Pragma("unroll") for (int bj = 0; bj < 2; ++bj) { \
            const u32x4 pw = pv[mm][bj], xw = xv[mm][bj]; \
            const f32x4 p0 = {bf_lo(pw.x), bf_hi(pw.x), bf_lo(pw.y), bf_hi(pw.y)}, p1 = {bf_lo(pw.z), bf_hi(pw.z), bf_lo(pw.w), bf_hi(pw.w)}; \
            const f32x4 a0 = acc[ai][bj][m][0] * rr + bv[bj][0], a1 = acc[ai][bj][m][1] * rr + bv[bj][1]; \
            f32x4 x0 = {h_lo(xw.x), h_hi(xw.x), h_lo(xw.y), h_hi(xw.y)}, x1 = {h_lo(xw.z), h_hi(xw.z), h_lo(xw.w), h_hi(xw.w)}; \
            _Pragma("unroll") for (int j = 0; j < 4; ++j) { \
                x0[j] += p0[j] * __builtin_amdgcn_rcpf(1.f + __builtin_amdgcn_exp2f(-a0[j] * LOG2E)); \
                x1[j] += p1[j] * __builtin_amdgcn_rcpf(1.f + __builtin_amdgcn_exp2f(-a1[j] * LOG2E)); } \
            acc[ai][bj][m][0] = x0; acc[ai][bj][m][1] = x1; } }
#define EP_STORE(ai, mp) _Pragma("unroll") for (int mm = 0; mm < 2; ++mm) { const int m = 2 * (mp) + mm; float ss = 0.f; _Pragma("unroll") for (int bj = 0; bj < 2; ++bj) { \
            const f32x4 x0 = acc[ai][bj][m][0], x1 = acc[ai][bj][m][1]; \
            u32x4 w; w.x = cvt_pk_f16(x0[0], x0[1]); w.y = cvt_pk_f16(x0[2], x0[3]); w.z = cvt_pk_f16(x1[0], x1[1]); w.w = cvt_pk_f16(x1[2], x1[3]); \
            *(u32x4*)(xout16 + base + (size_t)((ai) * HALF + m * 16) * D + bj * HALF) = w; \
            ss += (x0[0] * x0[0] + x0[1] * x0[1]) + (x0[2] * x0[2] + x0[3] * x0[3]) + (x1[0] * x1[0] + x1[1] * x1[1]) + (x1[2] * x1[2] + x1[3] * x1[3]); } \
            ssv[(ai) * 4 + m] = ss; }
        EP_LOAD(0, 0); EP_ADD(0, 0); EP_LOAD(0, 1); EP_STORE(0, 0); EP_ADD(0, 1); EP_LOAD(1, 0); EP_STORE(0, 1); EP_ADD(1, 0); EP_LOAD(1, 1); EP_STORE(1, 0); EP_ADD(1, 1); EP_STORE(1, 1);
#undef EP_LOAD
#undef EP_ADD
#undef EP_STORE
#pragma unroll
        for (int q = 0; q < 8; ++q) { ssv[q] += __shfl_xor(ssv[q], 16); }
#pragma unroll
        for (int q = 0; q < 8; ++q) { ssv[q] += __shfl_xor(ssv[q], 32); }
        if (fq == 0) {
#pragma unroll
            for (int q = 0; q < 8; ++q) ssq_add(ssq_out + row0 + (q >> 2) * HALF + (q & 3) * 16, ssv[q]);
        }
    }
};

template <bool F16, class Sched, class Epi>
__device__ __forceinline__ void gemm_phase(LAS unsigned char* lds, const Gemm g, const Sched& S, const Epi& E, int wave_s) {
    const int tid = tid_now(wave_s);
    const int wid = __builtin_amdgcn_readfirstlane(tid >> 6), lane = tid & 63, wr = wid >> 2, wc = wid & 3, fr = lane & 15, fq = lane >> 4;
    const int K = g.K, nt = K / BK, lda = g.lda;
    unsigned voffA[2], voffB[2];
#pragma unroll
    for (int i = 0; i < 2; ++i) { int R, C; stage_rc(tid * 16 + i * 8192, R, C); const int Rb = (R & ~31) + perm32(R & 31);
        voffA[i] = (unsigned)(R * lda + C) * 2u; voffB[i] = (unsigned)(Rb * K + C) * 2u; }
    const size_t kstep = (size_t)(BK * 2);
    const size_t hstepA = (size_t)HALF * lda * 2, hstepB = (size_t)HALF * K * 2;
    const size_t tstepA = 2 * hstepA, tstepB = 2 * hstepB;
    const unsigned ldsw = (unsigned)wid * 1024u;
    const int aoff = lds_byte(wr * 64 + fr, fq * 8), boff = lds_byte(wc * 32 + fr, fq * 8);
#define PG8_SA(b, h) (((b) * 2 + (h)) * HTB)
#define PG8_SB(b, h) ((4 + (b) * 2 + (h)) * HTB)
#define PG8_STAGE(bufoff, gbase, voff) do { _Pragma("unroll") for (int _i = 0; _i < 2; ++_i) \
        __builtin_amdgcn_global_load_lds((const unsigned*)((const char*)(gbase) + (voff)[_i]), (LAS unsigned*)(lds + (bufoff) + ldsw + _i * 8192), 16, 0, 0); } while (0)
#define PG8_LDA(dst, b, h) do { _Pragma("unroll") for (int m = 0; m < 4; ++m) _Pragma("unroll") for (int k = 0; k < 2; ++k) dst[m][k] = *(const LAS bf16x8*)(lds + PG8_SA(b, h) + aoff + m * 2048 + k * 1024); } while (0)
#define PG8_LDB(dst, b, h) do { _Pragma("unroll") for (int n = 0; n < 2; ++n) _Pragma("unroll") for (int k = 0; k < 2; ++k) dst[n][k] = *(const LAS bf16x8*)(lds + PG8_SB(b, h) + boff + n * 2048 + k * 1024); } while (0)
#define PG8_MMA(ai, bj, At, Bt) do { __builtin_amdgcn_s_setprio(1); _Pragma("unroll") for (int m = 0; m < 4; ++m) _Pragma("unroll") for (int n = 0; n < 2; ++n) _Pragma("unroll") for (int k = 0; k < 2; ++k) \
        acc[ai][bj][m][n] = F16 ? __builtin_amdgcn_mfma_f32_16x16x32_f16(__builtin_bit_cast(h16x8, Bt[n][k]), __builtin_bit_cast(h16x8, At[m][k]), acc[ai][bj][m][n], 0, 0, 0) \
                                : __builtin_amdgcn_mfma_f32_16x16x32_bf16(Bt[n][k], At[m][k], acc[ai][bj][m][n], 0, 0, 0); __builtin_amdgcn_s_setprio(0); } while (0)
#define PG8_WAIT_V(n) asm volatile("s_waitcnt vmcnt(" #n ")" ::: "memory")
#define PG8_WAIT_L(n) asm volatile("s_waitcnt lgkmcnt(" #n ")" ::: "memory")
#define PG8_BAR __builtin_amdgcn_s_barrier()
#define PG8_SCHED __builtin_amdgcn_sched_barrier(0)
#define PG8_AOFF(u) ((size_t)(u).pm * tstepA + (size_t)(((u).pn >> g.agrp_shift) * g.agrp_cols) * 2)
    Unit cur, nxt; int ui = 0;
    if (!S.next(0, cur)) return;
    f32x4 acc[2][2][4][2];
#pragma unroll
    for (int a = 0; a < 2; ++a)
#pragma unroll
        for (int b = 0; b < 2; ++b)
#pragma unroll
            for (int m = 0; m < 4; ++m)
#pragma unroll
                for (int n = 0; n < 2; ++n) acc[a][b][m][n] = (f32x4){0.f, 0.f, 0.f, 0.f};
    bf16x8 At[4][2], B0[2][2], B1[2][2];
    const char* cA = (const char*)g.A + PG8_AOFF(cur); const char* cB = (const char*)g.Bt + (size_t)cur.pn * tstepB;
    PG8_STAGE(PG8_SB(0, 0), cB, voffB); PG8_STAGE(PG8_SB(0, 1), cB + hstepB, voffB); PG8_STAGE(PG8_SA(0, 0), cA, voffA); PG8_STAGE(PG8_SA(0, 1), cA + hstepA, voffA);
    if (wr == 1) PG8_BAR;
    PG8_WAIT_V(2); PG8_BAR;
    PG8_STAGE(PG8_SB(1, 0), cB + kstep, voffB); PG8_STAGE(PG8_SA(1, 0), cA + kstep, voffA); PG8_STAGE(PG8_SB(1, 1), cB + hstepB + kstep, voffB);
    PG8_WAIT_V(6); PG8_BAR;
    for (;;) {
        const bool has_next = S.next(ui + 1, nxt);
        const char* nA = has_next ? (const char*)g.A + PG8_AOFF(nxt) : cA; const char* nB = has_next ? (const char*)g.Bt + (size_t)nxt.pn * tstepB : cB;
        for (int t = 0; t < nt; t += 2) {
            const bool last = (t == nt - 2);
            const char* a1 = cA + (size_t)(t + 1) * kstep;
            const char* a2 = last ? nA : cA + (size_t)(t + 2) * kstep; const char* b2 = last ? nB : cB + (size_t)(t + 2) * kstep;
            const char* a3 = a2 + kstep; const char* b3 = b2 + kstep;
            PG8_LDB(B0, 0, 0); PG8_LDB(B1, 0, 1); PG8_SCHED; PG8_LDA(At, 0, 0); PG8_STAGE(PG8_SA(1, 1), a1 + hstepA, voffA);
            PG8_WAIT_V(8); PG8_WAIT_L(0); PG8_BAR; PG8_MMA(0, 0, At, B0); PG8_MMA(0, 1, At, B1); PG8_BAR; PG8_SCHED;
            PG8_LDA(At, 0, 1); PG8_STAGE(PG8_SB(0, 0), b2, voffB); PG8_STAGE(PG8_SB(0, 1), b2 + hstepB, voffB); PG8_STAGE(PG8_SA(0, 0), a2, voffA);
            PG8_WAIT_V(8); PG8_WAIT_L(0); PG8_BAR; PG8_MMA(1, 0, At, B0); PG8_MMA(1, 1, At, B1); PG8_BAR; PG8_SCHED;
            PG8_LDB(B0, 1, 0); PG8_LDB(B1, 1, 1); PG8_SCHED; PG8_LDA(At, 1, 0); PG8_STAGE(PG8_SA(0, 1), a2 + hstepA, voffA);
            PG8_WAIT_V(8); PG8_WAIT_L(0); PG8_BAR; PG8_MMA(0, 0, At, B0); PG8_MMA(0, 1, At, B1); PG8_BAR; PG8_SCHED;
            PG8_LDA(At, 1, 1); PG8_STAGE(PG8_SB(1, 0), b3, voffB); PG8_STAGE(PG8_SB(1, 1), b3 + hstepB, voffB); PG8_STAGE(PG8_SA(1, 0), a3, voffA);
            PG8_WAIT_V(8); PG8_WAIT_L(0); PG8_BAR; PG8_MMA(1, 0, At, B0); PG8_MMA(1, 1, At, B1); PG8_BAR; PG8_SCHED;
        }
        if (wr == 0) PG8_BAR;
        E(acc, cur, wr, wc, fr, fq);
        if (!has_next) break;
#pragma unroll
        for (int a = 0; a < 2; ++a)
#pragma unroll
            for (int b = 0; b < 2; ++b)
#pragma unroll
                for (int m = 0; m < 4; ++m)
#pragma unroll
                    for (int n = 0; n < 2; ++n) acc[a][b][m][n] = (f32x4){0.f, 0.f, 0.f, 0.f};
        cur = nxt; cA = nA; cB = nB; ++ui;
        if (wr == 1) PG8_BAR;
    }
    PG8_WAIT_V(0);
    PG8_BAR;
#undef PG8_SA
#undef PG8_SB
#undef PG8_STAGE
#undef PG8_LDA
#undef PG8_LDB
#undef PG8_MMA
#undef PG8_WAIT_V
#undef PG8_WAIT_L
#undef PG8_BAR
#undef PG8_SCHED
#undef PG8_AOFF
}
}

using pg8::cvt_pk_bf16;

__device__ __forceinline__ float wave_sum(float v) {
#pragma unroll
    for (int o = 1; o < 64; o <<= 1) v += __shfl_xor(v, o);
    return v;
}

__device__ __forceinline__ void conv_item(const float* __restrict__ W, int N, bf16_t* __restrict__ WT, int ldk, int mode, int row_off, int n_lo, int nblk,
                                          const float* __restrict__ sn, const float* __restrict__ gk, float sc, int f16, LAS float* scr, int item, int lane) {
    const int kb = item / nblk, nb = item % nblk, k0 = 64 * kb, n0 = n_lo + 32 * nb;
    const float s = sc * (sn ? sn[n0 + (lane & 31)] : 1.f);
    const float* wp = W + (size_t)(k0 + (lane >> 5)) * N + n0 + (lane & 31);
    float v[32];
#pragma unroll
    for (int i = 0; i < 32; ++i) v[i] = __builtin_nontemporal_load(wp + (size_t)(2 * i) * N);
#pragma unroll
    for (int i = 0; i < 32; ++i) scr[(2 * i + (lane >> 5)) * 33 + (lane & 31)] = v[i] * s;
    asm volatile("s_waitcnt lgkmcnt(0)" ::: "memory");
    const int c = lane & 7;
    f32x4 g0 = {1.f, 1.f, 1.f, 1.f}, g1 = g0;
    if (gk) { g0 = *(const f32x4*)(gk + k0 + 8 * c); g1 = *(const f32x4*)(gk + k0 + 8 * c + 4); }
    const int nn0 = n0 - n_lo;
    const int drow0 = (mode == 0) ? row_off + nn0 : 256 * (nn0 >> 7) + 128 * (mode - 1) + (nn0 & 127);
#pragma unroll
    for (int j = 0; j < 4; ++j) { const int n = (lane >> 3) + 8 * j; const LAS float* sp = scr + (8 * c) * 33 + n;
        const float e0 = sp[0 * 33] * g0[0], e1 = sp[1 * 33] * g0[1], e2 = sp[2 * 33] * g0[2], e3 = sp[3 * 33] * g0[3], e4 = sp[4 * 33] * g1[0], e5 = sp[5 * 33] * g1[1], e6 = sp[6 * 33] * g1[2], e7 = sp[7 * 33] * g1[3];
        u32x4 o;
        if (f16) { o.x = pg8::cvt_pk_f16(e0, e1); o.y = pg8::cvt_pk_f16(e2, e3); o.z = pg8::cvt_pk_f16(e4, e5); o.w = pg8::cvt_pk_f16(e6, e7); }
        else { o.x = cvt_pk_bf16(e0, e1); o.y = cvt_pk_bf16(e2, e3); o.z = cvt_pk_bf16(e4, e5); o.w = cvt_pk_bf16(e6, e7); }
        *(u32x4*)(WT + (size_t)(drow0 + n) * ldk + k0 + 8 * c) = o; }
    asm volatile("s_waitcnt lgkmcnt(0)" ::: "memory");
}
__device__ __forceinline__ void conv_mat(const float* W, int K, int N, bf16_t* WT, int mode, int row_off, int n_lo, int n_hi, const float* sn, const float* gk, float sc, int f16,
                                         LAS float* scr, int& rot, int gw, int NGW, int lane) {
    const int nblk = (n_hi - n_lo) >> 5, nitems = (K >> 6) * nblk;
    int it = gw - rot; if (it < 0) it += NGW;
    for (; it < nitems; it += NGW) conv_item(W, N, WT, K, mode, row_off, n_lo, nblk, sn, gk, sc, f16, scr, it, lane);
    rot = (rot + nitems) % NGW;
}

__device__ __forceinline__ void xb_ssq_phase(const float* __restrict__ x, bf16_t* __restrict__ xb, float* __restrict__ ssq, int gw, int NGW, int lane) {
    for (int m = gw; m < NTOK; m += NGW) {
        const f32x4* xr = (const f32x4*)(x + (size_t)m * D) + lane;
        f32x4 v[8]; float s = 0.f;
#pragma unroll
        for (int j = 0; j < 8; ++j) { v[j] = xr[64 * j]; s += (v[j].x * v[j].x + v[j].y * v[j].y) + (v[j].z * v[j].z + v[j].w * v[j].w); }
        s = wave_sum(s);
        u32x2* o8 = (u32x2*)(xb + (size_t)m * D) + lane;
#pragma unroll
        for (int j = 0; j < 8; ++j) { u32x2 w; w.x = pg8::cvt_pk_f16(v[j].x, v[j].y); w.y = pg8::cvt_pk_f16(v[j].z, v[j].w); o8[64 * j] = w; }
        if (lane == 0) ssq[m] = s;
    }
}
__device__ __forceinline__ void final_norm_phase(const bf16_t* __restrict__ x16, const float* __restrict__ ssq, const float* __restrict__ g, float* __restrict__ out, int row_lo, int nrows, int gtid, int nthr) {
    for (int idx = row_lo * (D / 8) + gtid; idx < (row_lo + nrows) * (D / 8); idx += nthr) {
        const int row = idx >> 8, c8 = (idx & 255) * 8;
        const float r = pg8::rms_r(ssq[row]);
        const u32x4 w = ((const u32x4*)x16)[idx];
        const f32x4 g0 = *(const f32x4*)(g + c8), g1 = *(const f32x4*)(g + c8 + 4);
        f32x4* o = (f32x4*)(out + (size_t)row * D + c8);
        o[0] = (f32x4){pg8::h_lo(w.x), pg8::h_hi(w.x), pg8::h_lo(w.y), pg8::h_hi(w.y)} * r * g0;
        o[1] = (f32x4){pg8::h_lo(w.z), pg8::h_hi(w.z), pg8::h_lo(w.w), pg8::h_hi(w.w)} * r * g1;
    }
}

__device__ __forceinline__ void poolmix_phase(const bf16_t* __restrict__ XB, const float* __restrict__ ssq, const float* __restrict__ g, bf16_t* __restrict__ MX, int row_lo, int nrows, int gtid, int nthr) {
    for (int idx = row_lo * (D / 8) + gtid; idx < (row_lo + nrows) * (D / 8); idx += nthr) {
        const int tg = idx >> 8, ch = (idx & 255) * 8, grp = ch >> 9, w = 2 << grp;
        const int t = tg & (SEQ - 1);
        const int lo = max(t - (w >> 1), 0), hi = min(t + w - (w >> 1), SEQ);
        float a[8];
#pragma unroll
        for (int e = 0; e < 8; ++e) a[e] = 0.f;
        const bf16_t* base = XB + (size_t)(tg - t) * D + ch;
        const float* sb = ssq + (tg - t);
        for (int tt = lo; tt < hi; ++tt) {
            const u32x4 v = *(const u32x4*)(base + (size_t)tt * D);
            const float r = pg8::rms_r(sb[tt]);
            a[0] += pg8::h_lo(v.x) * r; a[1] += pg8::h_hi(v.x) * r; a[2] += pg8::h_lo(v.y) * r; a[3] += pg8::h_hi(v.y) * r;
            a[4] += pg8::h_lo(v.z) * r; a[5] += pg8::h_hi(v.z) * r; a[6] += pg8::h_lo(v.w) * r; a[7] += pg8::h_hi(v.w) * r;
        }
        const float inv = 1.f / (float)(hi - lo), rs = pg8::rms_r(sb[t]);
        const u32x4 sv = *(const u32x4*)(base + (size_t)t * D);
        const f32x4 g0 = *(const f32x4*)(g + ch), g1 = *(const f32x4*)(g + ch + 4);
        u32x4 o;
        o.x = cvt_pk_bf16((a[0] * inv - pg8::h_lo(sv.x) * rs) * g0[0], (a[1] * inv - pg8::h_hi(sv.x) * rs) * g0[1]);
        o.y = cvt_pk_bf16((a[2] * inv - pg8::h_lo(sv.y) * rs) * g0[2], (a[3] * inv - pg8::h_hi(sv.y) * rs) * g0[3]);
        o.z = cvt_pk_bf16((a[4] * inv - pg8::h_lo(sv.z) * rs) * g1[0], (a[5] * inv - pg8::h_hi(sv.z) * rs) * g1[1]);
        o.w = cvt_pk_bf16((a[6] * inv - pg8::h_lo(sv.w) * rs) * g1[2], (a[7] * inv - pg8::h_hi(sv.w) * rs) * g1[3]);
        *(u32x4*)(MX + (size_t)tg * D + ch) = o;
    }
}

__device__ __forceinline__ f32x4 mfma16(bf16x8 a, bf16x8 b, f32x4 c) { return __builtin_amdgcn_mfma_f32_16x16x32_bf16(a, b, c, 0, 0, 0); }

constexpr int AT_K = 0, AT_V = 61440, AT_B = 122880, AT_BCOPY = 3840 + 64;

__device__ __forceinline__ void attn_qblock(const bf16x8 qf, bf16_t* __restrict__ O, LAS unsigned char* lds,
                                            size_t tok0, int r, int r_start, int il0, int j, int h, int ql, int fq) {
    const int cs = (j == 0) ? 0 : (j == 1) ? 8 : (j == 2) ? 24 : 32;
    const int qc = 16 * j + ql;
    const int c_start = min(max(qc - 8, 0), 48);
    const size_t qtok = tok0 + (size_t)r * 64 + qc;
    const int t = cs + 8 * (ql >> 2) + (ql & 3);
    const LAS unsigned char* kp = lds + AT_K + (il0 * 64 + t) * 64 + ((fq ^ ((t >> 3) & 3)) * 16);
    const int x0 = cs + 8 * fq - qc + 31;
    const LAS unsigned char* bp = lds + AT_B + (x0 & 3) * AT_BCOPY + ((r_start - r + 7) * 64 + (x0 & ~3)) * 4;
    const LAS unsigned char* vp = lds + AT_V + (il0 * 32 + ql) * 128 + ((((cs >> 3) + fq) ^ ((ql >> 1) & 7)) * 16);
    const int kc0 = cs + 8 * fq - c_start;
    f32x4 sx[8], sy[8];
#pragma unroll
    for (int i = 0; i < 8; ++i) {
        const bf16x8 kx = *(const LAS bf16x8*)(kp + i * 4096), ky = *(const LAS bf16x8*)(kp + i * 4096 + 256);
        const f32x4 z = {0.f, 0.f, 0.f, 0.f};
        sx[i] = mfma16(kx, qf, z); sy[i] = mfma16(ky, qf, z);
    }
    float mx = -INFINITY;
#pragma unroll
    for (int i = 0; i < 8; ++i) {
        const f32x4 b0 = *(const LAS f32x4*)(bp + i * 256), b1 = *(const LAS f32x4*)(bp + i * 256 + 16);
#pragma unroll
        for (int e = 0; e < 4; ++e) {
            const float v = ((unsigned)(kc0 + e) < 16u) ? sx[i][e] + b0[e] : -INFINITY;
            const float w = ((unsigned)(kc0 + e + 4) < 16u) ? sy[i][e] + b1[e] : -INFINITY;
            sx[i][e] = v; sy[i][e] = w; mx = fmaxf(mx, fmaxf(v, w));
        }
    }
    mx = fmaxf(mx, __shfl_xor(mx, 16)); mx = fmaxf(mx, __shfl_xor(mx, 32));
    float l = 0.f;
    f32x4 o0 = {0.f, 0.f, 0.f, 0.f}, o1 = {0.f, 0.f, 0.f, 0.f};
#pragma unroll
    for (int i = 0; i < 8; ++i) {
        float p[8];
#pragma unroll
        for (int e = 0; e < 4; ++e) { p[e] = __builtin_amdgcn_exp2f(sx[i][e] - mx); p[e + 4] = __builtin_amdgcn_exp2f(sy[i][e] - mx); }
        l += ((p[0] + p[1]) + (p[2] + p[3])) + ((p[4] + p[5]) + (p[6] + p[7]));
        u32x4 pw; pw.x = cvt_pk_bf16(p[0], p[1]); pw.y = cvt_pk_bf16(p[2], p[3]); pw.z = cvt_pk_bf16(p[4], p[5]); pw.w = cvt_pk_bf16(p[6], p[7]);
        const bf16x8 pf = __builtin_bit_cast(bf16x8, pw);
        const bf16x8 v0 = *(const LAS bf16x8*)(vp + i * 4096), v1 = *(const LAS bf16x8*)(vp + i * 4096 + 2048);
        o0 = mfma16(v0, pf, o0); o1 = mfma16(v1, pf, o1);
    }
    l += __shfl_xor(l, 16); l += __shfl_xor(l, 32);
    const float inv = 1.f / l;
    bf16_t* op = O + qtok * D + h * 32 + 4 * fq;
    u32x2 w0, w1;
    w0.x = cvt_pk_bf16(o0[0] * inv, o0[1] * inv); w0.y = cvt_pk_bf16(o0[2] * inv, o0[3] * inv);
    w1.x = cvt_pk_bf16(o1[0] * inv, o1[1] * inv); w1.y = cvt_pk_bf16(o1[2] * inv, o1[3] * inv);
    *(u32x2*)op = w0; *(u32x2*)(op + 16) = w1;
}

__device__ __forceinline__ void attn_phase(const bf16_t* __restrict__ QK, const bf16_t* __restrict__ VT, const float* __restrict__ rpb, bf16_t* O, LAS unsigned char* lds, int grp, int gc, int gs, int tid, int wave, int lane) {
    const int ql = lane & 15, fq = lane >> 4;
    u32x4 kreg[8], vreg[8];
    const int nunits = 2 * (NH / gs);
#define AT_UNIT(u_, h_, rg_, b_, rlo_, nr_) const int h_ = gc + gs * ((u_) >> 1), rg_ = 2 * (grp & 1) + ((u_) & 1), b_ = grp >> 1; \
        const int rlo_ = min(max(8 * rg_ - 4, 0), 24), nr_ = min(max(8 * rg_ + 3, 0), 24) + 7 - rlo_ + 1;
#define AT_LOAD(u_) do { AT_UNIT(u_, h_, rg_, b_, rlo_, nr_) \
        const char* kb_ = (const char*)(QK + ((size_t)b_ * SEQ + (size_t)rlo_ * 64) * 4096 + 2048 + h_ * 32);            \
        _Pragma("unroll") for (int q = 0; q < 8; ++q) { if (tid + q * (NWAVES * 64) < nr_ * 256) kreg[q] = *(const u32x4*)(kb_ + (size_t)q * (128u * 8192u) + kvo); } \
        const char* vb_ = (const char*)(VT + (size_t)h_ * 32 * NTOK + (size_t)b_ * SEQ + (size_t)rlo_ * 64); \
        _Pragma("unroll") for (int q = 0; q < 8; ++q) { if ((tid & 15) + 16 * q < nr_ * 8) vreg[q] = *(const u32x4*)(vb_ + vvo + q * 256); } } while (0)
    const unsigned kvo = (unsigned)(tid >> 2) * 8192u + (unsigned)(tid & 3) * 16u;
    const unsigned vvo = (unsigned)(tid >> 4) * (unsigned)(NTOK * 2) + (unsigned)(tid & 15) * 16u;
    int u = 0, h_prev = -1;
    if (u < nunits) AT_LOAD(u);
    for (; u < nunits; ++u) {
        AT_UNIT(u, h, rg, b, r_lo, nrows)
        const size_t tok0 = (size_t)b * SEQ;
#pragma unroll
        for (int q = 0; q < 8; ++q) { const int idx = tid + q * (NWAVES * 64);
            if (idx < nrows * 256) { const int it = idx >> 2, ch = idx & 3, tt = it & 63; *(LAS u32x4*)(lds + AT_K + it * 64 + ((ch ^ ((tt >> 3) & 3)) * 16)) = kreg[q]; } }
#pragma unroll
        for (int q = 0; q < 8; ++q) { const int ic = (tid & 15) + 16 * q, d = tid >> 4;
            if (ic < nrows * 8) *(LAS u32x4*)(lds + AT_V + ((ic >> 3) * 32 + d) * 128 + (((ic & 7) ^ ((d >> 1) & 7)) * 16)) = vreg[q]; }
        if (h != h_prev) {
            for (int idx = tid; idx < 4 * 960; idx += NWAVES * 64) {
                const int c = idx / 960, rem = idx - c * 960, dr = rem >> 6, x = rem & 63, xi = x - 16 + c;
                *(LAS float*)(lds + AT_B + c * AT_BCOPY + rem * 4) = (xi >= 0 && xi < 31) ? rpb[(h * 15 + dr) * 31 + xi] * LOG2E : 0.f;
            }
            h_prev = h;
        }
        __syncthreads();
        {
            const int r = 8 * rg + wave, r_start = min(max(r - 4, 0), 24), il0 = r_start - r_lo;
            bf16x8 qf[4];
#pragma unroll
            for (int j = 0; j < 4; ++j) qf[j] = *(const bf16x8*)(QK + (tok0 + (size_t)r * 64 + 16 * j + ql) * 4096 + h * 32 + fq * 8);
            const int un = u + 1;
            if (un < nunits) AT_LOAD(un);
#pragma unroll 1
            for (int j = 0; j < 4; ++j) { const bf16x8 qj = (j == 0) ? qf[0] : (j == 1) ? qf[1] : (j == 2) ? qf[2] : qf[3]; attn_qblock(qj, O, lds, tok0, r, r_start, il0, j, h, ql, fq); }
        }
        __syncthreads();
    }
#undef AT_UNIT
#undef AT_LOAD
}

#define XB_TMO      128
#define XB_XCNT(j)  (256  + 64 * (j))
#define XB_XSUB(j)  (1280 + 64 * (j))
#define XB_XGEN(j)  (2304 + 64 * (j))
#define XB_TOP      3328
#define XB_TOPGEN   3392
#define XCD_BAR_WORDS 3456
#define XB_SPIN_CAP (1u << 22)
__device__ __forceinline__ unsigned xb_ld(unsigned* p)              { return __hip_atomic_load(p, __ATOMIC_RELAXED, __HIP_MEMORY_SCOPE_AGENT); }
__device__ __forceinline__ unsigned xb_add(unsigned* p, unsigned v) { return __hip_atomic_fetch_add(p, v, __ATOMIC_RELAXED, __HIP_MEMORY_SCOPE_AGENT); }
__device__ __forceinline__ unsigned xb_xcc_id() { return (unsigned)__builtin_amdgcn_s_getreg((3 << 11) | 20) & 0xFu; }
#define XB_SPIN(cond, bar) do { unsigned _sp = 0; while (cond) { __builtin_amdgcn_s_sleep(1); \
    if ((++_sp & 255u) == 0u) { if (xb_ld(&(bar)[XB_TMO])) break; if (_sp > XB_SPIN_CAP) { atomicAdd(&(bar)[XB_TMO], 1u); break; } } } } while (0)
struct XcdBarrier { unsigned* bar; unsigned x; volatile LAS unsigned* st; };
__device__ __forceinline__ void xcd_barrier_complete(unsigned* bar, unsigned x, unsigned& nloc, unsigned& nx) {
    const unsigned G = gridDim.x * gridDim.y * gridDim.z;
    unsigned sum, cnt, mine, sp = 0u;
    for (;;) {
        sum = 0u; cnt = 0u; mine = 0u;
#pragma unroll
        for (unsigned j = 0; j < 16; ++j) { const unsigned c = xb_ld(&bar[XB_XCNT(j)]); sum += c; cnt += (c > 0u) ? 1u : 0u; mine = (j == x) ? c : mine; }
        if (sum == G) break;
        __builtin_amdgcn_s_sleep(1);
        if ((++sp & 255u) == 0u) { if (xb_ld(&bar[XB_TMO])) break; if (sp > XB_SPIN_CAP) { atomicAdd(&bar[XB_TMO], 1u); break; } }
    }
    nloc = mine > 0u ? mine : 1u; nx = cnt > 0u ? cnt : 1u;
}
__device__ __forceinline__ void xcd_barrier(const XcdBarrier& b, bool tid0) {
    asm volatile("s_waitcnt vmcnt(0)" ::: "memory");
    __syncthreads();
    if (tid0) {
        unsigned* bar = b.bar;
        __builtin_amdgcn_s_waitcnt(0);
        unsigned nloc = b.st[0], nx = b.st[1];
        if (nloc == 0u) { xcd_barrier_complete(bar, b.x, nloc, nx); b.st[0] = nloc; b.st[1] = nx; }
        const unsigned old = xb_add(&bar[XB_XSUB(b.x)], 1u);
        const unsigned gen = old / nloc;
        if (old + 1u == (gen + 1u) * nloc) {
            __builtin_amdgcn_fence(__ATOMIC_RELEASE, "agent");
            asm volatile("s_waitcnt vmcnt(0)" ::: "memory");
            const unsigned og = xb_add(&bar[XB_TOP], 1u);
            const unsigned tg = og / nx;
            if (og + 1u == (tg + 1u) * nx) xb_add(&bar[XB_TOPGEN], 1u);
            else XB_SPIN(xb_ld(&bar[XB_TOPGEN]) == tg, bar);
            __builtin_amdgcn_fence(__ATOMIC_ACQUIRE, "agent");
            xb_add(&bar[XB_XGEN(b.x)], 1u);
            asm volatile("s_waitcnt vmcnt(0)" ::: "memory");
        } else {
            XB_SPIN(xb_ld(&bar[XB_XGEN(b.x)]) == gen, bar);
            __builtin_amdgcn_fence(__ATOMIC_ACQUIRE, "agent");
            asm volatile("s_waitcnt vmcnt(0)" ::: "memory");
        }
    }
    __syncthreads();
}

__device__ __forceinline__ void group_barrier(unsigned* cnt, unsigned gsize, bool tid0) {
    asm volatile("s_waitcnt vmcnt(0)" ::: "memory");
    __syncthreads();
    if (tid0) {
        __builtin_amdgcn_s_waitcnt(0);
        __builtin_amdgcn_fence(__ATOMIC_RELEASE, "agent");
        asm volatile("s_waitcnt vmcnt(0)" ::: "memory");
        const unsigned old = xb_add(cnt, 1u);
        const unsigned sh = (unsigned)__builtin_ctz(gsize);
        const unsigned target = ((old >> sh) + 1u) << sh;
        unsigned sp = 0u;
        while (xb_ld(cnt) < target) { __builtin_amdgcn_s_sleep(1); if (++sp > XB_SPIN_CAP) break; }
        __builtin_amdgcn_fence(__ATOMIC_ACQUIRE, "agent");
        asm volatile("s_waitcnt vmcnt(0)" ::: "memory");
    }
    __syncthreads();
}

struct Args { const float* in[19]; float* out; unsigned char* ws; };

typedef const __attribute__((address_space(4))) Args* ArgsP;
__device__ __forceinline__ ArgsP get_args() { ArgsP p = (ArgsP)__builtin_amdgcn_kernarg_segment_ptr(); asm volatile("" : "+s"(p)); return p; }
#define WSP(off) ((bf16_t*)(A->ws + (off)))

__global__ void __launch_bounds__(NWAVES * 64, 2) fwd_megakernel(Args args_unused) {
    extern __shared__ __attribute__((aligned(16))) unsigned char lds_raw[];
    LAS unsigned char* lds = (LAS unsigned char*)lds_raw;
    cg::grid_group grid = cg::this_grid();
    const int G = gridDim.x;
    const int wave_s = __builtin_amdgcn_readfirstlane((int)threadIdx.x >> 6);
    volatile LAS unsigned* bar_st = (volatile LAS unsigned*)(lds + LDS_BYTES - 16);
    if (threadIdx.x == 0) { bar_st[0] = 0u; bar_st[1] = 0u; }
    __syncthreads();
#define GRID_BAR() do { ArgsP A_ = get_args(); XcdBarrier b_; b_.bar = (unsigned*)(A_->ws + WS_BAR); b_.x = xb_xcc_id(); b_.st = bar_st; xcd_barrier(b_, tid_now(wave_s) == 0); } while (0)
#define IDS() const int tid_ = tid_now(wave_s); const int lane = tid_ & 63, wave = wave_s; \
    const int gw = blockIdx.x * NWAVES + wave, NGW = gridDim.x * NWAVES, gtid = blockIdx.x * (NWAVES * 64) + tid_, nthr = gridDim.x * NWAVES * 64; (void)lane; (void)gw; (void)NGW; (void)gtid; (void)nthr;

    {
        ArgsP A = get_args(); IDS();
        LAS float* scr = (LAS float*)(lds + wave * 16384);
        int rot = 0;
#pragma unroll 1
        for (int j = 0; j < 2; ++j) {
            const float* wq = A->in[3] + (size_t)j * D * 3 * D; const float* ga = A->in[2] + j * D;
            conv_mat(wq, D, 3 * D, WSP(WS_WQK) + (size_t)j * 4096 * D, 0, 0, 0, 2048, nullptr, ga, QSCALE, 1, scr, rot, gw, NGW, lane);
            conv_mat(wq, D, 3 * D, WSP(WS_WQK) + (size_t)j * 4096 * D, 0, 2048, 2048, 4096, nullptr, ga, 1.f, 1, scr, rot, gw, NGW, lane);
            conv_mat(wq, D, 3 * D, WSP(WS_WV) + (size_t)j * D * D, 0, 0, 4096, 6144, nullptr, ga, 1.f, 1, scr, rot, gw, NGW, lane);
            conv_mat(A->in[5] + (size_t)j * D * D, D, D, WSP(WS_WO) + (size_t)j * D * D, 0, 0, 0, D, nullptr, nullptr, 1.f, 0, scr, rot, gw, NGW, lane);
#pragma unroll 1
            for (int gI = 0; gI < 4; ++gI)
                conv_mat(A->in[8] + ((size_t)j * 4 + gI) * 512 * 512, 512, 512, WSP(WS_WPOOL) + (size_t)j * D * 512, 0, gI * 512, 0, 512, A->in[9] + j * D + gI * 512, nullptr, 1.f, 0, scr, rot, gw, NGW, lane);
        }
#pragma unroll 1
        for (int i = 0; i < DEPTH; ++i) {
            bf16_t* wgu_t = WSP(WS_WGU) + (size_t)i * 2 * DFF * D;
            conv_mat(A->in[11] + (size_t)i * D * DFF, D, DFF, wgu_t, 1, 0, 0, DFF, nullptr, A->in[10] + i * D, 1.f, 1, scr, rot, gw, NGW, lane);
            conv_mat(A->in[12] + (size_t)i * D * DFF, D, DFF, wgu_t, 2, 0, 0, DFF, nullptr, A->in[10] + i * D, 1.f, 1, scr, rot, gw, NGW, lane);
            if (i == 0) {
                conv_mat(A->in[13] + (size_t)i * DFF * D, DFF, D, WSP(WS_WD) + (size_t)i * D * DFF, 0, 0, 0, D, nullptr, nullptr, 1.f, 0, scr, rot, gw, NGW, lane);
                conv_mat(A->in[15] + (size_t)i * D * D, D, D, WSP(WS_WPG) + (size_t)i * D * D, 0, 0, 0, D, nullptr, A->in[14] + i * D, 1.f, 1, scr, rot, gw, NGW, lane);
            }
            conv_mat(A->in[17] + (size_t)i * PLE * D, PLE, D, WSP(WS_WPP) + (size_t)i * D * PLE, 0, 0, 0, D, nullptr, nullptr, 1.f, 0, scr, rot, gw, NGW, lane);
        }
        const f32x4* p4 = (const f32x4*)A->in[1]; u32x2* pb = (u32x2*)WSP(WS_PB);
        for (int idx = gtid; idx < DEPTH * NTOK * PLE / 4; idx += nthr) {
            const f32x4 v = p4[idx]; u32x2 w; w.x = cvt_pk_bf16(v.x, v.y); w.y = cvt_pk_bf16(v.z, v.w); pb[idx] = w;
        }
        float* ssq = (float*)(A->ws + WS_SSQ);
        for (int idx = gtid; idx < 12 * NTOK; idx += nthr) ssq[NTOK + idx] = 0.f;
        if (blockIdx.x == 0) for (int idx = tid_; idx < 4096 + 24 * 64; idx += NWAVES * 64) ((unsigned*)(A->ws + WS_BAR))[idx] = 0u;
        xb_ssq_phase(A->in[0], WSP(WS_H), ssq, gw, NGW, lane);
    }
    grid.sync();

#define SSQ(n) ((float*)(A->ws + WS_SSQ) + (size_t)(n) * NTOK)
#define XBCUR WSP((i & 1) ? WS_H2 : WS_H)
#define XBNXT WSP((i & 1) ? WS_H : WS_H2)
#define GRP ((int)blockIdx.x & 7)
#define GC ((int)blockIdx.x >> 3)
    const int GS = G >> 3;
#define GROUP_BAR() do { ArgsP A_ = get_args(); group_barrier((unsigned*)(A_->ws + WS_BAR) + 4096 + 64 * GRP, (unsigned)GS, tid_now(wave_s) == 0); } while (0)
#define PAIR_BAR() do { ArgsP A_ = get_args(); group_barrier((unsigned*)(A_->ws + WS_BAR) + 4096 + 64 * (8 + (GRP >> 1)), (unsigned)(2 * GS), tid_now(wave_s) == 0); } while (0)
#define CONV_WORD(n) ((unsigned*)(A_->ws + WS_BAR) + 4096 + 64 * (16 + (n)))
#define CONV_DONE(n) do { ArgsP A_ = get_args(); if (tid_now(wave_s) == 0) (void)xb_add(CONV_WORD(n), 1u); } while (0)
#define CONV_WAIT(n) do { ArgsP A_ = get_args(); if (tid_now(wave_s) == 0) { unsigned sp_ = 0u; while (xb_ld(CONV_WORD(n)) < (unsigned)(G / 2)) { __builtin_amdgcn_s_sleep(1); if (++sp_ > XB_SPIN_CAP) break; } \
        __builtin_amdgcn_fence(__ATOMIC_ACQUIRE, "agent"); asm volatile("s_waitcnt vmcnt(0)" ::: "memory"); } __syncthreads(); } while (0)
#define GIDS() IDS(); const int lgtid = GC * (NWAVES * 64) + tid_, lnthr = GS * (NWAVES * 64); (void)lgtid; (void)lnthr;
#pragma unroll 1
    for (int i = 0; i < DEPTH; ++i) {
        const int j = i >> 1;
        if ((i & 1) == 0) {
            {
                ArgsP A = get_args();
                pg8::GroupOrder S; S.init(0, 4096 / 256, GS, GC, GRP);
                pg8::Gemm g{XBCUR, WSP(WS_WQK) + (size_t)j * 4096 * D, NTOK, 4096, D, D, 0, 0};
                pg8::EpiBf16 E{WSP(WS_QK), 4096, A->in[4] + j * 3 * D, SSQ(3 * i), 8, QSCALE};
                pg8::gemm_phase<true>(lds, g, S, E, wave_s);
            }
            {
                ArgsP A = get_args();
                pg8::GroupOrder S; S.init(1, D / 256, GS, GC, GRP);
                pg8::Gemm g{WSP(WS_WV) + (size_t)j * D * D, XBCUR, D, NTOK, D, D, 0, 0};
                pg8::EpiVT E{WSP(WS_VT), A->in[4] + j * 3 * D + 4096, SSQ(3 * i)};
                pg8::gemm_phase<true>(lds, g, S, E, wave_s);
            }
            PAIR_BAR();
            { ArgsP A = get_args(); IDS(); attn_phase(WSP(WS_QK), WSP(WS_VT), A->in[6] + (size_t)j * NH * 15 * 31, WSP(WS_O), lds, GRP, GC, GS, tid_, wave, lane); }
            GROUP_BAR();
            {
                ArgsP A = get_args();
                pg8::GroupOrder S; S.init(0, D / 256, GS, GC, GRP);
                pg8::Gemm g{WSP(WS_O), WSP(WS_WO) + (size_t)j * D * D, NTOK, D, D, D, 0, 0};
                pg8::EpiResid E{XBCUR, SSQ(3 * i + 1)};
                pg8::gemm_phase<false>(lds, g, S, E, wave_s);
            }
            GROUP_BAR();
        } else {
            { ArgsP A = get_args(); GIDS(); poolmix_phase(XBCUR, SSQ(3 * i), A->in[7] + j * D, WSP(WS_O), 1024 * GRP, 1024, lgtid, lnthr); }
            PAIR_BAR();
            {
                ArgsP A = get_args();
                pg8::GroupOrder S; S.init(0, D / 256, GS, GC, GRP);
                pg8::Gemm g{WSP(WS_O), WSP(WS_WPOOL) + (size_t)j * D * 512, NTOK, D, 512, D, 1, 512};
                pg8::EpiResid E{XBCUR, SSQ(3 * i + 1)};
                pg8::gemm_phase<false>(lds, g, S, E, wave_s);
            }
            GROUP_BAR();
        }
        {
            ArgsP A = get_args();
            pg8::GroupOrder S; S.init(0, 2 * DFF / 256, GS, GC, GRP);
            pg8::Gemm g{XBCUR, WSP(WS_WGU) + (size_t)i * 2 * DFF * D, NTOK, 2 * DFF, D, D, 0, 0};
            pg8::EpiGU E{WSP(WS_ACT), SSQ(3 * i + 1)};
            pg8::gemm_phase<true>(lds, g, S, E, wave_s);
        }
        {
            ArgsP A = get_args();
            pg8::GroupOrder S; S.init(0, D / 256, GS / 2, GC - GS / 2, GRP);
            pg8::Gemm g{WSP(WS_PB) + (size_t)i * NTOK * PLE, WSP(WS_WPP) + (size_t)i * D * PLE, NTOK, D, PLE, PLE, 0, 0};
            pg8::EpiBf16 E{WSP(WS_PP), D, nullptr, nullptr, 0, 1.f};
            pg8::gemm_phase<false>(lds, g, S, E, wave_s);
        }
        if (i + 1 < DEPTH && GC >= GS / 2) {
            ArgsP A = get_args(); IDS();
            LAS float* scr = (LAS float*)(lds + wave * 16384);
            int rot = 0;
            const int hgw = ((GC - GS / 2) * 8 + GRP) * NWAVES + wave, hNGW = (G / 2) * NWAVES, n = i + 1;
            conv_mat(A->in[13] + (size_t)n * DFF * D, DFF, D, WSP(WS_WD) + (size_t)n * D * DFF, 0, 0, 0, D, nullptr, nullptr, 1.f, 0, scr, rot, hgw, hNGW, lane);
            conv_mat(A->in[15] + (size_t)n * D * D, D, D, WSP(WS_WPG) + (size_t)n * D * D, 0, 0, 0, D, nullptr, A->in[14] + n * D, 1.f, 1, scr, rot, hgw, hNGW, lane);
        }
        GROUP_BAR();
        if (i + 1 < DEPTH && GC >= GS / 2) CONV_DONE(i + 1);
        if (i > 0) CONV_WAIT(i);
        {
            ArgsP A = get_args();
            pg8::GroupOrder S; S.init(0, D / 256, GS, GC, GRP);
            pg8::Gemm g{WSP(WS_ACT), WSP(WS_WD) + (size_t)i * D * DFF, NTOK, D, DFF, DFF, 0, 0};
            pg8::EpiResid E{XBCUR, SSQ(3 * i + 2)};
            pg8::gemm_phase<false>(lds, g, S, E, wave_s);
        }
        GROUP_BAR();
        {
            ArgsP A = get_args();
            pg8::GroupOrder S; S.init(0, D / 256, GS, GC, GRP);
            pg8::Gemm g{XBCUR, WSP(WS_WPG) + (size_t)i * D * D, NTOK, D, D, D, 0, 0};
            pg8::EpiPle E{XBCUR, XBNXT, WSP(WS_PP), A->in[16] + i * D, SSQ(3 * i + 2), SSQ(3 * i + 3)};
            pg8::gemm_phase<true>(lds, g, S, E, wave_s);
        }
        if ((i & 1) == 0) PAIR_BAR(); else GROUP_BAR();
    }
    { ArgsP A = get_args(); GIDS(); final_norm_phase(WSP(WS_H), SSQ(12), A->in[18], A->out, 1024 * GRP, 1024, lgtid, lnthr); }
}

extern "C" void kernel_launch(void* const* d_in, const int* in_sizes, int n_in, void* d_out, int out_size, void* d_ws, size_t ws_size, hipStream_t stream) {
    static int grid = 0;
    if (grid == 0) {
        if (n_in != 19 || out_size != NTOK * D || ws_size < WS_END) { fprintf(stderr, "kernel_launch: unexpected shapes (n_in %d, out %d, ws %zu < %zu)\n", n_in, out_size, ws_size, (size_t)WS_END); grid = -1; return; }
        int dev = 0, cus = 0, per_cu = 0;
        hipGetDevice(&dev);
        hipDeviceGetAttribute(&cus, hipDeviceAttributeMultiprocessorCount, dev);
        if (hipFuncSetAttribute((const void*)fwd_megakernel, hipFuncAttributeMaxDynamicSharedMemorySize, LDS_BYTES) != hipSuccess) { fprintf(stderr, "kernel_launch: hipFuncSetAttribute failed\n"); grid = -1; return; }
        if (hipOccupancyMaxActiveBlocksPerMultiprocessor(&per_cu, (const void*)fwd_megakernel, NWAVES * 64, LDS_BYTES) != hipSuccess || per_cu < 1) { fprintf(stderr, "kernel_launch: occupancy query failed (%d)\n", per_cu); (void)hipGetLastError(); per_cu = 1; }
        grid = cus * per_cu;
        if (grid % 8 != 0 || ((grid / 8) & (grid / 8 - 1)) != 0 || NH % (grid / 8) != 0 || (NTOK / 256) % 8 != 0) { fprintf(stderr, "kernel_launch: grid %d is not a multiple of 8\n", grid); grid = -1; return; }
    }
    if (grid < 0) return;
    Args a{};
    for (int i = 0; i < 19; ++i) a.in[i] = (const float*)d_in[i];
    a.out = (float*)d_out; a.ws = (unsigned char*)d_ws;
    void* kargs[] = {&a};
    hipError_t e = hipLaunchCooperativeKernel((const void*)fwd_megakernel, dim3(grid), dim3(NWAVES * 64), kargs, LDS_BYTES, stream);
    if (e != hipSuccess) fprintf(stderr, "cooperative launch failed: %s (grid %d)\n", hipGetErrorString(e), grid);
}
```

```cpp
#include <hip/hip_runtime.h>
#include <hip/hip_cooperative_groups.h>
#include <cstdio>
#include <cstdint>
namespace cg = cooperative_groups;

#define LAS __attribute__((address_space(3)))
typedef unsigned short bf16_t;
typedef short bf16x8 __attribute__((ext_vector_type(8)));
typedef float f32x4 __attribute__((ext_vector_type(4)));
typedef unsigned u32x4 __attribute__((ext_vector_type(4)));
typedef unsigned u32x2 __attribute__((ext_vector_type(2)));

constexpr int D = 2048, NTOK = 8192, SEQ = 2048, DFF = 5632, PLE = 256, NH = 64, HD = 32, DEPTH = 4;
constexpr float RMS_EPS = 1e-6f;
constexpr float LOG2E = 1.4426950408889634f;
constexpr float QSCALE = 0.17677669529663687f * LOG2E;

constexpr size_t MiB = 1u << 20;
constexpr size_t WS_WQK = 0;
constexpr size_t WS_WV = WS_WQK + 32 * MiB;
constexpr size_t WS_WO = WS_WV + 16 * MiB;
constexpr size_t WS_WPOOL = WS_WO + 16 * MiB;
constexpr size_t WS_WGU = WS_WPOOL + 4 * MiB;
constexpr size_t WS_WD = WS_WGU + 176 * MiB;
constexpr size_t WS_WPG = WS_WD + 88 * MiB;
constexpr size_t WS_WPP = WS_WPG + 32 * MiB;
constexpr size_t WS_PB = WS_WPP + 4 * MiB;
constexpr size_t WS_H = WS_PB + 16 * MiB;
constexpr size_t WS_QK = WS_H + 32 * MiB;
constexpr size_t WS_VT = WS_QK + 64 * MiB;
constexpr size_t WS_O = WS_VT + 32 * MiB;
constexpr size_t WS_PP = WS_O + 32 * MiB;
constexpr size_t WS_SSQ = WS_PP + 32 * MiB;
constexpr size_t WS_H2 = WS_SSQ + 1 * MiB;
constexpr size_t WS_BAR = WS_H2 + 32 * MiB;
constexpr size_t WS_ACT = WS_BAR + 1 * MiB;
constexpr size_t WS_END = WS_ACT + 88 * MiB;

constexpr int NWAVES = 8;
constexpr int LDS_BYTES = 147456;

__device__ __forceinline__ int blk_now() { int b = (int)blockIdx.x; asm volatile("" : "+s"(b)); return b; }
__device__ __forceinline__ int tid_now(int wave_s) { int l; asm volatile("v_mbcnt_lo_u32_b32 %0, -1, 0\n\tv_mbcnt_hi_u32_b32 %0, -1, %0" : "=v"(l)); return wave_s * 64 + l; }

namespace pg8 {
constexpr int BM = 256, BK = 64, HALF = 128, HTB = HALF * BK * 2, NXCD = 8, WGM = 8;

__host__ __device__ __forceinline__ int lds_byte(int r, int c) { const int st = (r >> 4) * 2 + (c >> 5), rr = r & 15, cc = c & 31, ob = rr * 64 + cc * 2; return st * 1024 + (ob ^ (((ob >> 9) & 1) << 5)); }
__host__ __device__ __forceinline__ void stage_rc(int b, int& R, int& C) { const int st = b / 1024, sb = b % 1024, swz = sb ^ (((sb >> 9) & 1) << 5); R = (st >> 1) * 16 + swz / 64; C = (st & 1) * 32 + (swz % 64) / 2; }
__host__ __device__ __forceinline__ int perm32(int rho) { const int n = rho >> 4, i = rho & 15; return 8 * (i >> 2) + 4 * n + (i & 3); }

struct Unit { int pm, pn; };
struct Gemm { const bf16_t* A; const bf16_t* Bt; int M, N, K, lda, agrp_shift, agrp_cols; };

struct StaticOrder {
    int nM, nN, nwg, G, c;
    __device__ void init(int M, int N, int G_, int c_) { asm volatile("" : "+s"(c_)); nM = M / BM; nN = N / BM; nwg = nM * nN; G = G_; c = c_; }
    __device__ bool next(int i, Unit& u) const {
        if (c < 0) return false;
        const long L = (long)i * G + c; if (L >= nwg) return false;
        int wgid = (int)L; { const int q = nwg / NXCD, r = nwg % NXCD, xcd = wgid % NXCD, off = wgid / NXCD; wgid = (xcd < r ? xcd * (q + 1) : r * (q + 1) + (xcd - r) * q) + off; }
        const int nig = WGM * nN, gid = wgid / nig, fm = gid * WGM, gsz = (nM - fm) < WGM ? (nM - fm) : WGM;
        u.pm = fm + ((wgid % nig) % gsz); u.pn = (wgid % nig) / gsz; return true;
    }
};

struct GroupOrder {
    int nwg, G, c, p0, mode;
    __device__ void init(int mode_, int nOther, int G_, int c_, int grp) { asm volatile("" : "+s"(c_)); mode = mode_; nwg = 4 * nOther; G = G_; c = c_; p0 = 4 * grp; }
    __device__ bool next(int i, Unit& u) const {
        if (c < 0) return false;
        const int L = i * G + c; if (L >= nwg) return false;
        if (mode == 0) { u.pm = p0 + (L & 3); u.pn = L >> 2; } else { u.pm = L & 7; u.pn = p0 + (L >> 3); }
        return true;
    }
};

__device__ __forceinline__ unsigned cvt_pk_bf16(float lo, float hi) { unsigned r; asm("v_cvt_pk_bf16_f32 %0, %1, %2" : "=v"(r) : "v"(lo), "v"(hi)); return r; }
__device__ __forceinline__ float bf_lo(unsigned w) { return __builtin_bit_cast(float, w << 16); }
__device__ __forceinline__ float bf_hi(unsigned w) { return __builtin_bit_cast(float, w & 0xffff0000u); }
typedef _Float16 h16x2 __attribute__((ext_vector_type(2)));
typedef _Float16 h16x8 __attribute__((ext_vector_type(8)));
#define X_BF16 1
__device__ __forceinline__ unsigned cvt_pk_f16(float lo, float hi) { if (X_BF16) return cvt_pk_bf16(lo, hi); const h16x2 v = {(_Float16)lo, (_Float16)hi}; return __builtin_bit_cast(unsigned, v); }
__device__ __forceinline__ float h_lo(unsigned w) { if (X_BF16) return bf_lo(w); return (float)__builtin_bit_cast(_Float16, (unsigned short)(w & 0xffffu)); }
__device__ __forceinline__ float h_hi(unsigned w) { if (X_BF16) return bf_hi(w); return (float)__builtin_bit_cast(_Float16, (unsigned short)(w >> 16)); }

typedef f32x4 Acc[2][2][4][2];

typedef unsigned ssq_t;
constexpr float SSQ_ONE = 128.f;
__device__ __forceinline__ ssq_t ssq_fix(float v) { return (ssq_t)(v * SSQ_ONE + 0.5f); }
__device__ __forceinline__ float rms_r(ssq_t ssq) { float eps = RMS_EPS; asm volatile("" : "+v"(eps));
    return 1.f / sqrtf(fmaf((float)ssq, 1.f / (SSQ_ONE * D), eps)); }
__device__ __forceinline__ void ssq_add(ssq_t* p, float v) { __hip_atomic_fetch_add(p, ssq_fix(v), __ATOMIC_RELAXED, __HIP_MEMORY_SCOPE_AGENT); }

struct EpiBf16 {
    bf16_t* O; int ldc; const float* bias; const ssq_t* ssq; int nscale_tiles; float bscale;
    __device__ __forceinline__ void operator()(const Acc& acc, const Unit& u, int wr, int wc, int fr, int fq) const {
        const int row0 = u.pm * BM + wr * 64 + fr, col0 = u.pn * BM + wc * 32 + 8 * fq;
        const float bs = (u.pn < nscale_tiles) ? bscale : 1.f;
        f32x4 bv[2][2];
#pragma unroll
        for (int bj = 0; bj < 2; ++bj)
#pragma unroll
            for (int n = 0; n < 2; ++n) bv[bj][n] = bias ? *(const f32x4*)(bias + col0 + bj * HALF + 4 * n) * bs : (f32x4){0.f, 0.f, 0.f, 0.f};
        ssq_t rrv[8];
#pragma unroll
        for (int q = 0; q < 8; ++q) rrv[q] = ssq ? ssq[row0 + (q >> 2) * HALF + (q & 3) * 16] : 0u;
#pragma unroll
        for (int ai = 0; ai < 2; ++ai)
#pragma unroll
            for (int m = 0; m < 4; ++m) {
                const int row = row0 + ai * HALF + m * 16;
                const float rr = ssq ? rms_r(rrv[ai * 4 + m]) : 1.f;
                bf16_t* rowp = O + (size_t)row * ldc + col0;
#pragma unroll
                for (int bj = 0; bj < 2; ++bj) {
                    const f32x4 v0 = acc[ai][bj][m][0] * rr + bv[bj][0], v1 = acc[ai][bj][m][1] * rr + bv[bj][1];
                    u32x4 w; w.x = cvt_pk_bf16(v0[0], v0[1]); w.y = cvt_pk_bf16(v0[2], v0[3]); w.z = cvt_pk_bf16(v1[0], v1[1]); w.w = cvt_pk_bf16(v1[2], v1[3]);
                    *(u32x4*)(rowp + bj * HALF) = w;
                }
            }
    }
};

struct EpiVT {
    bf16_t* O; const float* bias; const ssq_t* ssq;
    __device__ __forceinline__ void operator()(const Acc& acc, const Unit& u, int wr, int wc, int fr, int fq) const {
        const int row0 = u.pm * BM + wr * 64 + fr, col0 = u.pn * BM + wc * 32 + 8 * fq;
        f32x4 rv[2][2];
#pragma unroll
        for (int bj = 0; bj < 2; ++bj)
#pragma unroll
            for (int n = 0; n < 2; ++n) { const ssq_t* s = ssq + col0 + bj * HALF + 4 * n; rv[bj][n] = (f32x4){rms_r(s[0]), rms_r(s[1]), rms_r(s[2]), rms_r(s[3])}; }
        float brv[8];
#pragma unroll
        for (int q = 0; q < 8; ++q) brv[q] = bias[row0 + (q >> 2) * HALF + (q & 3) * 16];
#pragma unroll
        for (int ai = 0; ai < 2; ++ai)
#pragma unroll
            for (int m = 0; m < 4; ++m) {
                const int row = row0 + ai * HALF + m * 16;
                const float br = brv[ai * 4 + m];
                bf16_t* rowp = O + (size_t)row * NTOK + col0;
#pragma unroll
                for (int bj = 0; bj < 2; ++bj) {
                    const f32x4 v0 = acc[ai][bj][m][0] * rv[bj][0] + br, v1 = acc[ai][bj][m][1] * rv[bj][1] + br;
                    u32x4 w; w.x = cvt_pk_bf16(v0[0], v0[1]); w.y = cvt_pk_bf16(v0[2], v0[3]); w.z = cvt_pk_bf16(v1[0], v1[1]); w.w = cvt_pk_bf16(v1[2], v1[3]);
                    *(u32x4*)(rowp + bj * HALF) = w;
                }
            }
    }
};

struct EpiResid {
    bf16_t* x16; ssq_t* ssq_out;
    __device__ __forceinline__ void operator()(Acc& acc, const Unit& u, int wr, int wc, int fr, int fq) const {
        const int row0 = u.pm * BM + wr * 64 + fr, col0 = u.pn * BM + wc * 32 + 8 * fq;
        const size_t base = (size_t)row0 * D + col0;
        u32x4 xv[4][2];
        float ssv[8];
#define ER_LOAD(ai) _Pragma("unroll") for (int m = 0; m < 4; ++m) _Pragma("unroll") for (int bj = 0; bj < 2; ++bj) xv[m][bj] = *(const u32x4*)(x16 + base + (size_t)((ai) * HALF + m * 16) * D + bj * HALF);
#define ER_ADD(ai) _Pragma("unroll") for (int m = 0; m < 4; ++m) _Pragma("unroll") for (int bj = 0; bj < 2; ++bj) { const u32x4 w = xv[m][bj]; \
            acc[ai][bj][m][0] += (f32x4){h_lo(w.x), h_hi(w.x), h_lo(w.y), h_hi(w.y)}; acc[ai][bj][m][1] += (f32x4){h_lo(w.z), h_hi(w.z), h_lo(w.w), h_hi(w.w)}; }
#define ER_STORE(ai) _Pragma("unroll") for (int m = 0; m < 4; ++m) { float ss = 0.f; _Pragma("unroll") for (int bj = 0; bj < 2; ++bj) { \
            const f32x4 x0 = acc[ai][bj][m][0], x1 = acc[ai][bj][m][1]; \
            u32x4 w; w.x = cvt_pk_f16(x0[0], x0[1]); w.y = cvt_pk_f16(x0[2], x0[3]); w.z = cvt_pk_f16(x1[0], x1[1]); w.w = cvt_pk_f16(x1[2], x1[3]); \
            *(u32x4*)(x16 + base + (size_t)((ai) * HALF + m * 16) * D + bj * HALF) = w; \
            ss += (x0[0] * x0[0] + x0[1] * x0[1]) + (x0[2] * x0[2] + x0[3] * x0[3]) + (x1[0] * x1[0] + x1[1] * x1[1]) + (x1[2] * x1[2] + x1[3] * x1[3]); } \
            ssv[(ai) * 4 + m] = ss; }
        ER_LOAD(0); ER_ADD(0); ER_LOAD(1); ER_STORE(0); ER_ADD(1); ER_STORE(1);
#undef ER_LOAD
#undef ER_ADD
#undef ER_STORE
#pragma unroll
        for (int q = 0; q < 8; ++q) { ssv[q] += __shfl_xor(ssv[q], 16); }
#pragma unroll
        for (int q = 0; q < 8; ++q) { ssv[q] += __shfl_xor(ssv[q], 32); }
        if (fq == 0) {
#pragma unroll
            for (int q = 0; q < 8; ++q) ssq_add(ssq_out + row0 + (q >> 2) * HALF + (q & 3) * 16, ssv[q]);
        }
    }
};

struct EpiGU {
    bf16_t* O; const LAS float* lr;
    __device__ __forceinline__ void operator()(const Acc& acc, const Unit& u, int wr, int wc, int fr, int fq) const {
        const int row0 = u.pm * BM + wr * 64 + fr, col0 = u.pn * HALF + wc * 32 + 8 * fq;
        float rrv[8];
#pragma unroll
        for (int q = 0; q < 8; ++q) rrv[q] = lr[wr * 64 + fr + (q >> 2) * HALF + (q & 3) * 16];
#pragma unroll
        for (int ai = 0; ai < 2; ++ai)
#pragma unroll
            for (int m = 0; m < 4; ++m) {
                const int row = row0 + ai * HALF + m * 16;
                const float rr = rrv[ai * 4 + m];
                float r[8];
#pragma unroll
                for (int n = 0; n < 2; ++n)
#pragma unroll
                    for (int j = 0; j < 4; ++j) {
                        const float g = acc[ai][0][m][n][j] * rr, up = acc[ai][1][m][n][j] * rr;
                        r[n * 4 + j] = g * __builtin_amdgcn_rcpf(1.f + __builtin_amdgcn_exp2f(-g * LOG2E)) * up;
                    }
                u32x4 w; w.x = cvt_pk_bf16(r[0], r[1]); w.y = cvt_pk_bf16(r[2], r[3]); w.z = cvt_pk_bf16(r[4], r[5]); w.w = cvt_pk_bf16(r[6], r[7]);
                *(u32x4*)(O + (size_t)row * DFF + col0) = w;
            }
    }
};

struct EpiPle {
    const bf16_t* xin16; bf16_t* xout16; const bf16_t* pp; const float* bias; const ssq_t* ssq_in; ssq_t* ssq_out;
    __device__ __forceinline__ void operator()(Acc& acc, const Unit& u, int wr, int wc, int fr, int fq) const {
        const int row0 = u.pm * BM + wr * 64 + fr, col0 = u.pn * BM + wc * 32 + 8 * fq;
        const size_t base = (size_t)row0 * D + col0;
        f32x4 bv[2][2];
#pragma unroll
        for (int bj = 0; bj < 2; ++bj)
#pragma unroll
            for (int n = 0; n < 2; ++n) bv[bj][n] = *(const f32x4*)(bias + col0 + bj * HALF + 4 * n);
        ssq_t rrv[8]; float ssv[8];
#pragma unroll
        for (int q = 0; q < 8; ++q) rrv[q] = ssq_in[row0 + (q >> 2) * HALF + (q & 3) * 16];
        u32x4 xv[2][2], pv[2][2];
#define EP_LOAD(ai, mp) _Pragma("unroll") for (int mm = 0; mm < 2; ++mm) _Pragma("unroll") for (int bj = 0; bj < 2; ++bj) { const size_t off = base + (size_t)((ai) * HALF + (2 * (mp) + mm) * 16) * D + bj * HALF; \
            xv[mm][bj] = *(const u32x4*)(xin16 + off); pv[mm][bj] = *(const u32x4*)(pp + off); }
#define EP_ADD(ai, mp) _Pragma("unroll") for (int mm = 0; mm < 2; ++mm) { const int m = 2 * (mp) + mm; const float rr = rms_r(rrv[(ai) * 4 + m]); _Pragma("unroll") for (int bj = 0; bj < 2; ++bj) { \
            const u32x4 pw = pv[mm][bj], xw = xv[mm][bj]; \
            const f32x4 p0 = {bf_lo(pw.x), bf_hi(pw.x), bf_lo(pw.y), bf_hi(pw.y)}, p1 = {bf_lo(pw.z), bf_hi(pw.z), bf_lo(pw.w), bf_hi(pw.w)}; \
            const f32x4 a0 = acc[ai][bj][m][0] * rr + bv[bj][0], a1 = acc[ai][bj][m][1] * rr + bv[bj][1]; \
            f32x4 x0 = {h_lo(xw.x), h_hi(xw.x), h_lo(xw.y), h_hi(xw.y)}, x1 = {h_lo(xw.z), h_hi(xw.z), h_lo(xw.w), h_hi(xw.w)}; \
            _Pragma("unroll") for (int j = 0; j < 4; ++j) { \
                x0[j] += p0[j] * __builtin_amdgcn_rcpf(1.f + __builtin_amdgcn_exp2f(-a0[j] * LOG2E)); \
                x1[j] += p1[j] * __builtin_amdgcn_rcpf(1.f + __builtin_amdgcn_exp2f(-a1[j] * LOG2E)); } \
            acc[ai][bj][m][0] = x0; acc[ai][bj][m][1] = x1; } }
#define EP_STORE(ai, mp) _Pragma("unroll") for (int mm = 0; mm < 2; ++mm) { const int m = 2 * (mp) + mm; float ss = 0.f; _Pragma("unroll") for (int bj = 0; bj < 2; ++bj) { \
            const f32x4 x0 = acc[ai][bj][m][0], x1 = acc[ai][bj][m][1]; \
            u32x4 w; w.x = cvt_pk_f16(x0[0], x0[1]); w.y = cvt_pk_f16(x0[2], x0[3]); w.z = cvt_pk_f16(x1[0], x1[1]); w.w = cvt_pk_f16(x1[2], x1[3]); \
            if (xout16) *(u32x4*)(xout16 + base + (size_t)((ai) * HALF + m * 16) * D + bj * HALF) = w; \
            ss += (x0[0] * x0[0] + x0[1] * x0[1]) + (x0[2] * x0[2] + x0[3] * x0[3]) + (x1[0] * x1[0] + x1[1] * x1[1]) + (x1[2] * x1[2] + x1[3] * x1[3]); } \
            ssv[(ai) * 4 + m] = ss; }
        EP_LOAD(0, 0); EP_ADD(0, 0); EP_LOAD(0, 1); EP_STORE(0, 0); EP_ADD(0, 1); EP_LOAD(1, 0); EP_STORE(0, 1); EP_ADD(1, 0); EP_LOAD(1, 1); EP_STORE(1, 0); EP_ADD(1, 1); EP_STORE(1, 1);
#undef EP_LOAD
#undef EP_ADD
#undef EP_STORE
#pragma unroll
        for (int q = 0; q < 8; ++q) { ssv[q] += __shfl_xor(ssv[q], 16); }
#pragma unroll
        for (int q = 0; q < 8; ++q) { ssv[q] += __shfl_xor(ssv[q], 32); }
        if (fq == 0) {
#pragma unroll
            for (int q = 0; q < 8; ++q) ssq_add(ssq_out + row0 + (q >> 2) * HALF + (q & 3) * 16, ssv[q]);
        }
    }
};

template <bool F16, class Sched, class Epi>
__device__ __forceinline__ void gemm_phase(LAS unsigned char* lds, const Gemm g, const Sched& S, const Epi& E, int wave_s) {
    const int tid = tid_now(wave_s);
    const int wid = __builtin_amdgcn_readfirstlane(tid >> 6), lane = tid & 63, wr = wid >> 2, wc = wid & 3, fr = lane & 15, fq = lane >> 4;
    const int K = g.K, nt = K / BK, lda = g.lda;
    unsigned voffA[2], voffB[2];
#pragma unroll
    for (int i = 0; i < 2; ++i) { int R, C; stage_rc(tid * 16 + i * 8192, R, C); const int Rb = (R & ~31) + perm32(R & 31);
        voffA[i] = (unsigned)(R * lda + C) * 2u; voffB[i] = (unsigned)(Rb * K + C) * 2u; }
    const size_t kstep = (size_t)(BK * 2);
    const size_t hstepA = (size_t)HALF * lda * 2, hstepB = (size_t)HALF * K * 2;
    const size_t tstepA = 2 * hstepA, tstepB = 2 * hstepB;
    const unsigned ldsw = (unsigned)wid * 1024u;
    const int aoff = lds_byte(wr * 64 + fr, fq * 8), boff = lds_byte(wc * 32 + fr, fq * 8);
#define PG8_SA(b, h) (((b) * 2 + (h)) * HTB)
#define PG8_SB(b, h) ((4 + (b) * 2 + (h)) * HTB)
#define PG8_STAGE(bufoff, gbase, voff) do { _Pragma("unroll") for (int _i = 0; _i < 2; ++_i) \
        __builtin_amdgcn_global_load_lds((const unsigned*)((const char*)(gbase) + (voff)[_i]), (LAS unsigned*)(lds + (bufoff) + ldsw + _i * 8192), 16, 0, 0); } while (0)
#define PG8_LDA(dst, b, h) do { _Pragma("unroll") for (int m = 0; m < 4; ++m) _Pragma("unroll") for (int k = 0; k < 2; ++k) dst[m][k] = *(const LAS bf16x8*)(lds + PG8_SA(b, h) + aoff + m * 2048 + k * 1024); } while (0)
#define PG8_LDB(dst, b, h) do { _Pragma("unroll") for (int n = 0; n < 2; ++n) _Pragma("unroll") for (int k = 0; k < 2; ++k) dst[n][k] = *(const LAS bf16x8*)(lds + PG8_SB(b, h) + boff + n * 2048 + k * 1024); } while (0)
#define PG8_MMA(ai, bj, At, Bt) do { __builtin_amdgcn_s_setprio(1); _Pragma("unroll") for (int m = 0; m < 4; ++m) _Pragma("unroll") for (int n = 0; n < 2; ++n) _Pragma("unroll") for (int k = 0; k < 2; ++k) \
        acc[ai][bj][m][n] = (F16 && !X_BF16) ? __builtin_amdgcn_mfma_f32_16x16x32_f16(__builtin_bit_cast(h16x8, Bt[n][k]), __builtin_bit_cast(h16x8, At[m][k]), acc[ai][bj][m][n], 0, 0, 0) \
                                : __builtin_amdgcn_mfma_f32_16x16x32_bf16(Bt[n][k], At[m][k], acc[ai][bj][m][n], 0, 0, 0); __builtin_amdgcn_s_setprio(0); } while (0)
#define PG8_WAIT_V(n) asm volatile("s_waitcnt vmcnt(" #n ")" ::: "memory")
#define PG8_WAIT_L(n) asm volatile("s_waitcnt lgkmcnt(" #n ")" ::: "memory")
#define PG8_BAR __builtin_amdgcn_s_barrier()
#define PG8_SCHED __builtin_amdgcn_sched_barrier(0)
#define PG8_AOFF(u) ((size_t)(u).pm * tstepA + (size_t)(((u).pn >> g.agrp_shift) * g.agrp_cols) * 2)
    Unit cur, nxt; int ui = 0;
    if (!S.next(0, cur)) return;
    f32x4 acc[2][2][4][2];
#pragma unroll
    for (int a = 0; a < 2; ++a)
#pragma unroll
        for (int b = 0; b < 2; ++b)
#pragma unroll
            for (int m = 0; m < 4; ++m)
#pragma unroll
                for (int n = 0; n < 2; ++n) acc[a][b][m][n] = (f32x4){0.f, 0.f, 0.f, 0.f};
    bf16x8 At[4][2], B0[2][2], B1[2][2];
    const char* cA = (const char*)g.A + PG8_AOFF(cur); const char* cB = (const char*)g.Bt + (size_t)cur.pn * tstepB;
    PG8_STAGE(PG8_SB(0, 0), cB, voffB); PG8_STAGE(PG8_SB(0, 1), cB + hstepB, voffB); PG8_STAGE(PG8_SA(0, 0), cA, voffA); PG8_STAGE(PG8_SA(0, 1), cA + hstepA, voffA);
    if (wr == 1) PG8_BAR;
    PG8_WAIT_V(2); PG8_BAR;
    PG8_STAGE(PG8_SB(1, 0), cB + kstep, voffB); PG8_STAGE(PG8_SA(1, 0), cA + kstep, voffA); PG8_STAGE(PG8_SB(1, 1), cB + hstepB + kstep, voffB);
    PG8_WAIT_V(6); PG8_BAR;
    for (;;) {
        const bool has_next = S.next(ui + 1, nxt);
        const char* nA = has_next ? (const char*)g.A + PG8_AOFF(nxt) : cA + (size_t)(nt - 2) * kstep; const char* nB = has_next ? (const char*)g.Bt + (size_t)nxt.pn * tstepB : cB + (size_t)(nt - 2) * kstep;
        for (int t = 0; t < nt; t += 2) {
            const bool last = (t == nt - 2);
            const char* a1 = cA + (size_t)(t + 1) * kstep;
            const char* a2 = last ? nA : cA + (size_t)(t + 2) * kstep; const char* b2 = last ? nB : cB + (size_t)(t + 2) * kstep;
            const char* a3 = a2 + kstep; const char* b3 = b2 + kstep;
            PG8_LDB(B0, 0, 0); PG8_LDB(B1, 0, 1); PG8_SCHED; PG8_LDA(At, 0, 0); PG8_STAGE(PG8_SA(1, 1), a1 + hstepA, voffA);
            PG8_WAIT_V(8); PG8_WAIT_L(0); PG8_BAR; PG8_MMA(0, 0, At, B0); PG8_MMA(0, 1, At, B1); PG8_BAR; PG8_SCHED;
            PG8_LDA(At, 0, 1); PG8_STAGE(PG8_SB(0, 0), b2, voffB); PG8_STAGE(PG8_SB(0, 1), b2 + hstepB, voffB); PG8_STAGE(PG8_SA(0, 0), a2, voffA);
            PG8_WAIT_V(8); PG8_WAIT_L(0); PG8_BAR; PG8_MMA(1, 0, At, B0); PG8_MMA(1, 1, At, B1); PG8_BAR; PG8_SCHED;
            PG8_LDB(B0, 1, 0); PG8_LDB(B1, 1, 1); PG8_SCHED; PG8_LDA(At, 1, 0); PG8_STAGE(PG8_SA(0, 1), a2 + hstepA, voffA);
            PG8_WAIT_V(8); PG8_WAIT_L(0); PG8_BAR; PG8_MMA(0, 0, At, B0); PG8_MMA(0, 1, At, B1); PG8_BAR; PG8_SCHED;
            PG8_LDA(At, 1, 1); PG8_STAGE(PG8_SB(1, 0), b3, voffB); PG8_STAGE(PG8_SB(1, 1), b3 + hstepB, voffB); PG8_STAGE(PG8_SA(1, 0), a3, voffA);
            PG8_WAIT_V(8); PG8_WAIT_L(0); PG8_BAR; PG8_MMA(1, 0, At, B0); PG8_MMA(1, 1, At, B1); PG8_BAR; PG8_SCHED;
        }
        if (wr == 0) PG8_BAR;
        E(acc, cur, wr, wc, fr, fq);
        if (!has_next) break;
#pragma unroll
        for (int a = 0; a < 2; ++a)
#pragma unroll
            for (int b = 0; b < 2; ++b)
#pragma unroll
                for (int m = 0; m < 4; ++m)
#pragma unroll
                    for (int n = 0; n < 2; ++n) acc[a][b][m][n] = (f32x4){0.f, 0.f, 0.f, 0.f};
        cur = nxt; cA = nA; cB = nB; ++ui;
        if (wr == 1) PG8_BAR;
    }
    PG8_WAIT_V(0);
    PG8_BAR;
#undef PG8_SA
#undef PG8_SB
#undef PG8_STAGE
#undef PG8_LDA
#undef PG8_LDB
#undef PG8_MMA
#undef PG8_WAIT_V
#undef PG8_WAIT_L
#undef PG8_BAR
#undef PG8_SCHED
#undef PG8_AOFF
}
}

using pg8::cvt_pk_bf16;

__device__ __forceinline__ float wave_sum(float v) {
#pragma unroll
    for (int o = 1; o < 64; o <<= 1) v += __shfl_xor(v, o);
    return v;
}

__device__ __forceinline__ void conv_item(const float* __restrict__ W, int N, bf16_t* __restrict__ WT, int ldk, int mode, int row_off, int n_lo, int nblk,
                                          const float* __restrict__ sn, const float* __restrict__ gk, float sc, int f16, LAS float* scr, int item, int lane) {
    const int kb = item / nblk, nb = item % nblk, k0 = 64 * kb, n0 = n_lo + 32 * nb;
    const float s = sc * (sn ? sn[n0 + (lane & 31)] : 1.f);
    const float* wp = W + (size_t)(k0 + (lane >> 5)) * N + n0 + (lane & 31);
    float v[32];
#pragma unroll
    for (int i = 0; i < 32; ++i) v[i] = __builtin_nontemporal_load(wp + (size_t)(2 * i) * N);
#pragma unroll
    for (int i = 0; i < 32; ++i) scr[(2 * i + (lane >> 5)) * 33 + (lane & 31)] = v[i] * s;
    asm volatile("s_waitcnt lgkmcnt(0)" ::: "memory");
    const int c = lane & 7;
    f32x4 g0 = {1.f, 1.f, 1.f, 1.f}, g1 = g0;
    if (gk) { g0 = *(const f32x4*)(gk + k0 + 8 * c); g1 = *(const f32x4*)(gk + k0 + 8 * c + 4); }
    const int nn0 = n0 - n_lo;
    const int drow0 = (mode == 0) ? row_off + nn0 : 256 * (nn0 >> 7) + 128 * (mode - 1) + (nn0 & 127);
#pragma unroll
    for (int j = 0; j < 4; ++j) { const int n = (lane >> 3) + 8 * j; const LAS float* sp = scr + (8 * c) * 33 + n;
        const float e0 = sp[0 * 33] * g0[0], e1 = sp[1 * 33] * g0[1], e2 = sp[2 * 33] * g0[2], e3 = sp[3 * 33] * g0[3], e4 = sp[4 * 33] * g1[0], e5 = sp[5 * 33] * g1[1], e6 = sp[6 * 33] * g1[2], e7 = sp[7 * 33] * g1[3];
        u32x4 o;
        if (f16) { o.x = pg8::cvt_pk_f16(e0, e1); o.y = pg8::cvt_pk_f16(e2, e3); o.z = pg8::cvt_pk_f16(e4, e5); o.w = pg8::cvt_pk_f16(e6, e7); }
        else { o.x = cvt_pk_bf16(e0, e1); o.y = cvt_pk_bf16(e2, e3); o.z = cvt_pk_bf16(e4, e5); o.w = cvt_pk_bf16(e6, e7); }
        *(u32x4*)(WT + (size_t)(drow0 + n) * ldk + k0 + 8 * c) = o; }
    asm volatile("s_waitcnt lgkmcnt(0)" ::: "memory");
}
__device__ __forceinline__ void conv_mat(const float* W, int K, int N, bf16_t* WT, int mode, int row_off, int n_lo, int n_hi, const float* sn, const float* gk, float sc, int f16,
                                         LAS float* scr, int& rot, int gw, int NGW, int lane) {
    const int nblk = (n_hi - n_lo) >> 5, nitems = (K >> 6) * nblk;
    int it = gw - rot; if (it < 0) it += NGW;
    for (; it < nitems; it += NGW) conv_item(W, N, WT, K, mode, row_off, n_lo, nblk, sn, gk, sc, f16, scr, it, lane);
    rot = (rot + nitems) % NGW;
}

__device__ __forceinline__ void xb_ssq_phase(const float* __restrict__ x, bf16_t* __restrict__ xb, pg8::ssq_t* __restrict__ ssq, int gw, int NGW, int lane) {
    for (int m = gw; m < NTOK; m += NGW) {
        const f32x4* xr = (const f32x4*)(x + (size_t)m * D) + lane;
        f32x4 v[8]; float s = 0.f;
#pragma unroll
        for (int j = 0; j < 8; ++j) { v[j] = xr[64 * j]; s += (v[j].x * v[j].x + v[j].y * v[j].y) + (v[j].z * v[j].z + v[j].w * v[j].w); }
        s = wave_sum(s);
        u32x2* o8 = (u32x2*)(xb + (size_t)m * D) + lane;
#pragma unroll
        for (int j = 0; j < 8; ++j) { u32x2 w; w.x = pg8::cvt_pk_f16(v[j].x, v[j].y); w.y = pg8::cvt_pk_f16(v[j].z, v[j].w); o8[64 * j] = w; }
        if (lane == 0) ssq[m] = pg8::ssq_fix(s);
    }
}
__device__ __forceinline__ void final_norm_phase(const bf16_t* __restrict__ x16, const pg8::ssq_t* __restrict__ ssq, const float* __restrict__ g, float* __restrict__ out, int row_lo, int nrows, int gtid, int nthr) {
    for (int idx = row_lo * (D / 8) + gtid; idx < (row_lo + nrows) * (D / 8); idx += nthr) {
        const int row = idx >> 8, c8 = (idx & 255) * 8;
        const float r = pg8::rms_r(ssq[row]);
        const u32x4 w = ((const u32x4*)x16)[idx];
        const f32x4 g0 = *(const f32x4*)(g + c8), g1 = *(const f32x4*)(g + c8 + 4);
        f32x4* o = (f32x4*)(out + (size_t)row * D + c8);
        o[0] = (f32x4){pg8::h_lo(w.x), pg8::h_hi(w.x), pg8::h_lo(w.y), pg8::h_hi(w.y)} * r * g0;
        o[1] = (f32x4){pg8::h_lo(w.z), pg8::h_hi(w.z), pg8::h_lo(w.w), pg8::h_hi(w.w)} * r * g1;
    }
}

__device__ __forceinline__ void poolmix_phase(const bf16_t* __restrict__ XB, const pg8::ssq_t* __restrict__ ssq, const float* __restrict__ g, bf16_t* __restrict__ MX, int row_lo, int nrows, int gtid, int nthr, LAS unsigned char* lds, int tid) {
    LAS float* rl = (LAS float*)lds;
    for (int q = tid; q < nrows + 16; q += NWAVES * 64) rl[q] = pg8::rms_r(ssq[min(max(row_lo - 8 + q, 0), NTOK - 1)]);
    __syncthreads();
#define PM_V(tt, sgn) do { if ((unsigned)(tt) < (unsigned)SEQ) { const u32x4 v_ = *(const u32x4*)(base + (size_t)(tt) * D); const float r_ = (sgn) * sb[tt]; \
        a[0] += pg8::h_lo(v_.x) * r_; a[1] += pg8::h_hi(v_.x) * r_; a[2] += pg8::h_lo(v_.y) * r_; a[3] += pg8::h_hi(v_.y) * r_; \
        a[4] += pg8::h_lo(v_.z) * r_; a[5] += pg8::h_hi(v_.z) * r_; a[6] += pg8::h_lo(v_.w) * r_; a[7] += pg8::h_hi(v_.w) * r_; } } while (0)
    for (int item = gtid; item < (nrows >> 4) * (D / 8); item += nthr) {
        const int ch = (item & 255) * 8, seg = item >> 8, grp = ch >> 9, w = 2 << grp, hw = w >> 1;
        const int tg0 = row_lo + seg * 16, t0 = tg0 & (SEQ - 1), seq0 = tg0 - t0;
        const bf16_t* base = XB + (size_t)seq0 * D + ch;
        const LAS float* sb = rl + (seq0 - (row_lo - 8));
        const f32x4 g0 = *(const f32x4*)(g + ch), g1 = *(const f32x4*)(g + ch + 4);
        float a[8];
#pragma unroll
        for (int e = 0; e < 8; ++e) a[e] = 0.f;
        for (int tt = t0 - hw; tt < t0 + w - hw; ++tt) PM_V(tt, 1.f);
#pragma unroll 1
        for (int k = 0; k < 16; ++k) {
            const int t = t0 + k;
            const int lo = max(t - hw, 0), hi = min(t + w - hw, SEQ);
            const float inv = 1.f / (float)(hi - lo), rs = sb[t];
            const u32x4 sv = *(const u32x4*)(base + (size_t)t * D);
            u32x4 o;
            o.x = cvt_pk_bf16((a[0] * inv - pg8::h_lo(sv.x) * rs) * g0[0], (a[1] * inv - pg8::h_hi(sv.x) * rs) * g0[1]);
            o.y = cvt_pk_bf16((a[2] * inv - pg8::h_lo(sv.y) * rs) * g0[2], (a[3] * inv - pg8::h_hi(sv.y) * rs) * g0[3]);
            o.z = cvt_pk_bf16((a[4] * inv - pg8::h_lo(sv.z) * rs) * g1[0], (a[5] * inv - pg8::h_hi(sv.z) * rs) * g1[1]);
            o.w = cvt_pk_bf16((a[6] * inv - pg8::h_lo(sv.w) * rs) * g1[2], (a[7] * inv - pg8::h_hi(sv.w) * rs) * g1[3]);
            *(u32x4*)(MX + (size_t)(tg0 + k) * D + ch) = o;
            PM_V(t + w - hw, 1.f); PM_V(t - hw, -1.f);
        }
    }
#undef PM_V
}

__device__ __forceinline__ f32x4 mfma16(bf16x8 a, bf16x8 b, f32x4 c) { return __builtin_amdgcn_mfma_f32_16x16x32_bf16(a, b, c, 0, 0, 0); }

constexpr int AT_K = 0, AT_V = 61440, AT_B = 122880, AT_BCOPY = 3840 + 64;

__device__ __forceinline__ void attn_qblock(const bf16x8 qf, bf16_t* __restrict__ O, LAS unsigned char* lds,
                                            size_t tok0, int r, int r_start, int il0, int j, int h, int ql, int fq) {
    const int cs = (j == 0) ? 0 : (j == 1) ? 8 : (j == 2) ? 24 : 32;
    const int qc = 16 * j + ql;
    const int c_start = min(max(qc - 8, 0), 48);
    const size_t qtok = tok0 + (size_t)r * 64 + qc;
    const int t = cs + 8 * (ql >> 2) + (ql & 3);
    const LAS unsigned char* kp = lds + AT_K + (il0 * 64 + t) * 64 + ((fq ^ ((t >> 3) & 3)) * 16);
    const int x0 = cs + 8 * fq - qc + 31;
    const LAS unsigned char* bp = lds + AT_B + (x0 & 3) * AT_BCOPY + ((r_start - r + 7) * 64 + (x0 & ~3)) * 4;
    const LAS unsigned char* vp = lds + AT_V + (il0 * 32 + ql) * 128 + ((((cs >> 3) + fq) ^ ((ql >> 1) & 7)) * 16);
    const int kc0 = cs + 8 * fq - c_start;
    f32x4 sx[8], sy[8];
#pragma unroll
    for (int i = 0; i < 8; ++i) {
        const bf16x8 kx = *(const LAS bf16x8*)(kp + i * 4096), ky = *(const LAS bf16x8*)(kp + i * 4096 + 256);
        const f32x4 z = {0.f, 0.f, 0.f, 0.f};
        sx[i] = mfma16(kx, qf, z); sy[i] = mfma16(ky, qf, z);
        if (i == 3) __builtin_amdgcn_sched_barrier(0);
    }
    __builtin_amdgcn_sched_barrier(0);
#pragma unroll
    for (int i = 0; i < 8; ++i) {
        const f32x4 b0 = *(const LAS f32x4*)(bp + i * 256), b1 = *(const LAS f32x4*)(bp + i * 256 + 16);
#pragma unroll
        for (int e = 0; e < 4; ++e) {
            sx[i][e] = ((unsigned)(kc0 + e) < 16u) ? sx[i][e] + b0[e] : -INFINITY;
            sy[i][e] = ((unsigned)(kc0 + e + 4) < 16u) ? sy[i][e] + b1[e] : -INFINITY;
        }
    }
    __builtin_amdgcn_sched_barrier(0);
    const bf16x8 ones = {(short)0x3F80, (short)0x3F80, (short)0x3F80, (short)0x3F80, (short)0x3F80, (short)0x3F80, (short)0x3F80, (short)0x3F80};
    f32x4 o0 = {0.f, 0.f, 0.f, 0.f}, o1 = {0.f, 0.f, 0.f, 0.f}, ol = {0.f, 0.f, 0.f, 0.f};
#pragma unroll
    for (int i = 0; i < 8; ++i) {
        float p[8];
#pragma unroll
        for (int e = 0; e < 4; ++e) { p[e] = __builtin_amdgcn_exp2f(sx[i][e]); p[e + 4] = __builtin_amdgcn_exp2f(sy[i][e]); }
        u32x4 pw; pw.x = cvt_pk_bf16(p[0], p[1]); pw.y = cvt_pk_bf16(p[2], p[3]); pw.z = cvt_pk_bf16(p[4], p[5]); pw.w = cvt_pk_bf16(p[6], p[7]);
        const bf16x8 pf = __builtin_bit_cast(bf16x8, pw);
        const bf16x8 v0 = *(const LAS bf16x8*)(vp + i * 4096), v1 = *(const LAS bf16x8*)(vp + i * 4096 + 2048);
        o0 = mfma16(v0, pf, o0); o1 = mfma16(v1, pf, o1); ol = mfma16(ones, pf, ol);
    }
    const float inv = 1.f / ol[0];
    bf16_t* op = O + qtok * D + h * 32 + 4 * fq;
    u32x2 w0, w1;
    w0.x = cvt_pk_bf16(o0[0] * inv, o0[1] * inv); w0.y = cvt_pk_bf16(o0[2] * inv, o0[3] * inv);
    w1.x = cvt_pk_bf16(o1[0] * inv, o1[1] * inv); w1.y = cvt_pk_bf16(o1[2] * inv, o1[3] * inv);
    *(u32x2*)op = w0; *(u32x2*)(op + 16) = w1;
}

__device__ __forceinline__ void attn_phase(const bf16_t* __restrict__ QK, const bf16_t* __restrict__ VT, const float* __restrict__ rpb, bf16_t* O, LAS unsigned char* lds, int grp, int gc, int gs, int tid, int wave, int lane) {
    const int ql = lane & 15, fq = lane >> 4;
    u32x4 kreg[8], vreg[8];
    const int nunits = 2 * (NH / gs);
#define AT_UNIT(u_, h_, rg_, b_, rlo_, nr_) const int h_ = gc + gs * ((u_) >> 1), rg_ = 2 * (grp & 1) + ((u_) & 1), b_ = grp >> 1; \
        const int rlo_ = min(max(8 * rg_ - 4, 0), 24), nr_ = min(max(8 * rg_ + 3, 0), 24) + 7 - rlo_ + 1;
#define AT_LOAD(u_) do { AT_UNIT(u_, h_, rg_, b_, rlo_, nr_) \
        const char* kb_ = (const char*)(QK + ((size_t)b_ * SEQ + (size_t)rlo_ * 64) * 4096 + 2048 + h_ * 32);            \
        _Pragma("unroll") for (int q = 0; q < 8; ++q) { if (tid + q * (NWAVES * 64) < nr_ * 256) kreg[q] = *(const u32x4*)(kb_ + (size_t)q * (128u * 8192u) + kvo); } \
        const char* vb_ = (const char*)(VT + (size_t)h_ * 32 * NTOK + (size_t)b_ * SEQ + (size_t)rlo_ * 64); \
        _Pragma("unroll") for (int q = 0; q < 8; ++q) { if ((tid & 15) + 16 * q < nr_ * 8) vreg[q] = *(const u32x4*)(vb_ + vvo + q * 256); } } while (0)
    const unsigned kvo = (unsigned)(tid >> 2) * 8192u + (unsigned)(tid & 3) * 16u;
    const unsigned vvo = (unsigned)(tid >> 4) * (unsigned)(NTOK * 2) + (unsigned)(tid & 15) * 16u;
    int u = 0, h_prev = -1;
    if (u < nunits) AT_LOAD(u);
    for (; u < nunits; ++u) {
        AT_UNIT(u, h, rg, b, r_lo, nrows)
        const size_t tok0 = (size_t)b * SEQ;
#pragma unroll
        for (int q = 0; q < 8; ++q) { const int idx = tid + q * (NWAVES * 64);
            if (idx < nrows * 256) { const int it = idx >> 2, ch = idx & 3, tt = it & 63; *(LAS u32x4*)(lds + AT_K + it * 64 + ((ch ^ ((tt >> 3) & 3)) * 16)) = kreg[q]; } }
#pragma unroll
        for (int q = 0; q < 8; ++q) { const int ic = (tid & 15) + 16 * q, d = tid >> 4;
            if (ic < nrows * 8) *(LAS u32x4*)(lds + AT_V + ((ic >> 3) * 32 + d) * 128 + (((ic & 7) ^ ((d >> 1) & 7)) * 16)) = vreg[q]; }
        if (h != h_prev) {
            for (int idx = tid; idx < 4 * 960; idx += NWAVES * 64) {
                const int c = idx / 960, rem = idx - c * 960, dr = rem >> 6, x = rem & 63, xi = x - 16 + c;
                *(LAS float*)(lds + AT_B + c * AT_BCOPY + rem * 4) = (xi >= 0 && xi < 31) ? rpb[(h * 15 + dr) * 31 + xi] * LOG2E : 0.f;
            }
            h_prev = h;
        }
        __syncthreads();
        {
            const int r = 8 * rg + wave, r_start = min(max(r - 4, 0), 24), il0 = r_start - r_lo;
            bf16x8 qf[4];
#pragma unroll
            for (int j = 0; j < 4; ++j) qf[j] = *(const bf16x8*)(QK + (tok0 + (size_t)r * 64 + 16 * j + ql) * 4096 + h * 32 + fq * 8);
            const int un = u + 1;
            if (un < nunits) AT_LOAD(un);
#pragma unroll 1
            for (int j = 0; j < 4; ++j) { const bf16x8 qj = (j == 0) ? qf[0] : (j == 1) ? qf[1] : (j == 2) ? qf[2] : qf[3]; attn_qblock(qj, O, lds, tok0, r, r_start, il0, j, h, ql, fq); }
        }
        __syncthreads();
    }
#undef AT_UNIT
#undef AT_LOAD
}

#define XB_TMO      128
#define XB_XCNT(j)  (256  + 64 * (j))
#define XB_XSUB(j)  (1280 + 64 * (j))
#define XB_XGEN(j)  (2304 + 64 * (j))
#define XB_TOP      3328
#define XB_TOPGEN   3392
#define XCD_BAR_WORDS 3456
#define XB_SPIN_CAP (1u << 22)
__device__ __forceinline__ unsigned xb_ld(unsigned* p)              { return __hip_atomic_load(p, __ATOMIC_RELAXED, __HIP_MEMORY_SCOPE_AGENT); }
__device__ __forceinline__ unsigned xb_add(unsigned* p, unsigned v) { return __hip_atomic_fetch_add(p, v, __ATOMIC_RELAXED, __HIP_MEMORY_SCOPE_AGENT); }
__device__ __forceinline__ unsigned xb_xcc_id() { unsigned r; asm volatile("s_getreg_b32 %0, hwreg(20, 0, 4)" : "=s"(r)); return r & 0xFu; }
#define XB_SPIN(cond, bar) do { unsigned _sp = 0; while (cond) { __builtin_amdgcn_s_sleep(1); \
    if ((++_sp & 255u) == 0u) { if (xb_ld(&(bar)[XB_TMO])) break; if (_sp > XB_SPIN_CAP) { atomicAdd(&(bar)[XB_TMO], 1u); break; } } } } while (0)
struct XcdBarrier { unsigned* bar; unsigned x; volatile LAS unsigned* st; unsigned G; };
__device__ __forceinline__ void xcd_barrier_complete(unsigned* bar, unsigned x, unsigned G, unsigned& nloc, unsigned& nx) {
    unsigned sum, cnt, mine, sp = 0u;
    for (;;) {
        sum = 0u; cnt = 0u; mine = 0u;
#pragma unroll
        for (unsigned j = 0; j < 16; ++j) { const unsigned c = xb_ld(&bar[XB_XCNT(j)]); sum += c; cnt += (c > 0u) ? 1u : 0u; mine = (j == x) ? c : mine; }
        if (sum == G) break;
        __builtin_amdgcn_s_sleep(1);
        if ((++sp & 255u) == 0u) { if (xb_ld(&bar[XB_TMO])) break; if (sp > XB_SPIN_CAP) { atomicAdd(&bar[XB_TMO], 1u); break; } }
    }
    nloc = mine > 0u ? mine : 1u; nx = cnt > 0u ? cnt : 1u;
}
__device__ __forceinline__ void xcd_barrier(const XcdBarrier& b, bool tid0) {
    asm volatile("s_waitcnt vmcnt(0)" ::: "memory");
    __syncthreads();
    if (tid0) {
        unsigned* bar = b.bar;
        __builtin_amdgcn_s_waitcnt(0);
        unsigned nloc = b.st[0], nx = b.st[1];
        if (nloc == 0u) { xcd_barrier_complete(bar, b.x, b.G, nloc, nx); b.st[0] = nloc; b.st[1] = nx; }
        const unsigned old = xb_add(&bar[XB_XSUB(b.x)], 1u);
        const unsigned gen = old / nloc;
        if (old + 1u == (gen + 1u) * nloc) {
            __builtin_amdgcn_fence(__ATOMIC_RELEASE, "agent");
            asm volatile("s_waitcnt vmcnt(0)" ::: "memory");
            const unsigned og = xb_add(&bar[XB_TOP], 1u);
            const unsigned tg = og / nx;
            if (og + 1u == (tg + 1u) * nx) xb_add(&bar[XB_TOPGEN], 1u);
            else XB_SPIN(xb_ld(&bar[XB_TOPGEN]) == tg, bar);
            __builtin_amdgcn_fence(__ATOMIC_ACQUIRE, "agent");
            xb_add(&bar[XB_XGEN(b.x)], 1u);
            asm volatile("s_waitcnt vmcnt(0)" ::: "memory");
        } else {
            XB_SPIN(xb_ld(&bar[XB_XGEN(b.x)]) == gen, bar);
            __builtin_amdgcn_fence(__ATOMIC_ACQUIRE, "agent");
            asm volatile("s_waitcnt vmcnt(0)" ::: "memory");
        }
    }
    __syncthreads();
}

struct EpiPleFinal {
    pg8::EpiPle base; const float* gfin; float* out; XcdBarrier bar; int wave_s;
    __device__ __forceinline__ void operator()(pg8::Acc& acc, const pg8::Unit& u, int wr, int wc, int fr, int fq) const {
        base(acc, u, wr, wc, fr, fq);
        xcd_barrier(bar, tid_now(wave_s) == 0);
        const int row0 = u.pm * pg8::BM + wr * 64 + fr, col0 = u.pn * pg8::BM + wc * 32 + 8 * fq;
        f32x4 gv[2][2];
#pragma unroll
        for (int bj = 0; bj < 2; ++bj)
#pragma unroll
            for (int n = 0; n < 2; ++n) gv[bj][n] = *(const f32x4*)(gfin + col0 + bj * pg8::HALF + 4 * n);
        pg8::ssq_t sv[8];
#pragma unroll
        for (int q = 0; q < 8; ++q) sv[q] = base.ssq_out[row0 + (q >> 2) * pg8::HALF + (q & 3) * 16];
#pragma unroll
        for (int ai = 0; ai < 2; ++ai)
#pragma unroll
            for (int m = 0; m < 4; ++m) {
                const float rr = pg8::rms_r(sv[ai * 4 + m]);
                float* op = out + (size_t)(row0 + ai * pg8::HALF + m * 16) * D + col0;
#pragma unroll
                for (int bj = 0; bj < 2; ++bj) {
                    *(f32x4*)(op + bj * pg8::HALF) = acc[ai][bj][m][0] * rr * gv[bj][0];
                    *(f32x4*)(op + bj * pg8::HALF + 4) = acc[ai][bj][m][1] * rr * gv[bj][1];
                }
            }
    }
};

struct Args { const float* in[19]; float* out; unsigned char* ws; };

typedef const __attribute__((address_space(4))) Args* ArgsP;
__device__ __forceinline__ ArgsP get_args() { ArgsP p = (ArgsP)__builtin_amdgcn_kernarg_segment_ptr(); asm volatile("" : "+s"(p)); return p; }
#define WSP(off) ((bf16_t*)(A->ws + (off)))

__global__ void __launch_bounds__(NWAVES * 64, 2) fwd_megakernel(Args args_unused) {
    extern __shared__ __attribute__((aligned(16))) unsigned char lds_raw[];
    LAS unsigned char* lds = (LAS unsigned char*)lds_raw;
    cg::grid_group grid = cg::this_grid();
    const int G = gridDim.x;
    const int wave_s = __builtin_amdgcn_readfirstlane((int)threadIdx.x >> 6);
    volatile LAS unsigned* bar_st = (volatile LAS unsigned*)(lds + LDS_BYTES - 32);
    if (threadIdx.x == 0) { for (int q = 0; q < 8; ++q) bar_st[q] = 0u; }
    __syncthreads();
    { ArgsP A = get_args(); if (tid_now(wave_s) == 0) { unsigned* bw = (unsigned*)(A->ws + WS_BAR); const unsigned xc = xb_xcc_id(); const int g_ = blk_now() & 7;
        (void)xb_add(bw + 4096 * g_ + XB_XCNT(xc), 1u); (void)xb_add(bw + 4096 * (8 + (g_ >> 1)) + XB_XCNT(xc), 1u); (void)xb_add(bw + 4096 * 12 + XB_XCNT(xc), 1u); } }
#define IDS() const int tid_ = tid_now(wave_s); const int lane = tid_ & 63, wave = wave_s; \
    const int gw = blockIdx.x * NWAVES + wave, NGW = gridDim.x * NWAVES, gtid = blockIdx.x * (NWAVES * 64) + tid_, nthr = gridDim.x * NWAVES * 64; (void)lane; (void)gw; (void)NGW; (void)gtid; (void)nthr;

    {
        ArgsP A = get_args(); IDS();
        LAS float* scr = (LAS float*)(lds + wave * 16384);
        int rot = 0;
#pragma unroll 1
        for (int j = 0; j < 2; ++j) {
            const float* wq = A->in[3] + (size_t)j * D * 3 * D; const float* ga = A->in[2] + j * D;
            conv_mat(wq, D, 3 * D, WSP(WS_WQK) + (size_t)j * 4096 * D, 0, 0, 0, 2048, nullptr, ga, QSCALE, 1, scr, rot, gw, NGW, lane);
            conv_mat(wq, D, 3 * D, WSP(WS_WQK) + (size_t)j * 4096 * D, 0, 2048, 2048, 4096, nullptr, ga, 1.f, 1, scr, rot, gw, NGW, lane);
            conv_mat(wq, D, 3 * D, WSP(WS_WV) + (size_t)j * D * D, 0, 0, 4096, 6144, nullptr, ga, 1.f, 1, scr, rot, gw, NGW, lane);
            conv_mat(A->in[5] + (size_t)j * D * D, D, D, WSP(WS_WO) + (size_t)j * D * D, 0, 0, 0, D, nullptr, nullptr, 1.f, 0, scr, rot, gw, NGW, lane);
#pragma unroll 1
            for (int gI = 0; gI < 4; ++gI)
                conv_mat(A->in[8] + ((size_t)j * 4 + gI) * 512 * 512, 512, 512, WSP(WS_WPOOL) + (size_t)j * D * 512, 0, gI * 512, 0, 512, A->in[9] + j * D + gI * 512, nullptr, 1.f, 0, scr, rot, gw, NGW, lane);
        }
#pragma unroll 1
        for (int i = 0; i < DEPTH; ++i) {
            bf16_t* wgu_t = WSP(WS_WGU) + (size_t)i * 2 * DFF * D;
            if (i == 0) conv_mat(A->in[11] + (size_t)i * D * DFF, D, DFF, wgu_t, 1, 0, 0, DFF, nullptr, A->in[10] + i * D, 1.f, 1, scr, rot, gw, NGW, lane);
            conv_mat(A->in[12] + (size_t)i * D * DFF, D, DFF, wgu_t, 2, 0, 0, DFF, nullptr, A->in[10] + i * D, 1.f, 1, scr, rot, gw, NGW, lane);
            if (i == 0) {
                conv_mat(A->in[13] + (size_t)i * DFF * D, DFF, D, WSP(WS_WD) + (size_t)i * D * DFF, 0, 0, 0, D, nullptr, nullptr, 1.f, 0, scr, rot, gw, NGW, lane);
                conv_mat(A->in[15] + (size_t)i * D * D, D, D, WSP(WS_WPG) + (size_t)i * D * D, 0, 0, 0, D, nullptr, A->in[14] + i * D, 1.f, 1, scr, rot, gw, NGW, lane);
            }
            conv_mat(A->in[17] + (size_t)i * PLE * D, PLE, D, WSP(WS_WPP) + (size_t)i * D * PLE, 0, 0, 0, D, nullptr, nullptr, 1.f, 0, scr, rot, gw, NGW, lane);
        }
        const f32x4* p4 = (const f32x4*)A->in[1]; u32x2* pb = (u32x2*)WSP(WS_PB);
        for (int idx = gtid; idx < DEPTH * NTOK * PLE / 4; idx += nthr) {
            const f32x4 v = p4[idx]; u32x2 w; w.x = cvt_pk_bf16(v.x, v.y); w.y = cvt_pk_bf16(v.z, v.w); pb[idx] = w;
        }
        pg8::ssq_t* ssq = (pg8::ssq_t*)(A->ws + WS_SSQ);
        for (int idx = gtid; idx < 12 * NTOK; idx += nthr) ssq[NTOK + idx] = 0u;
        xb_ssq_phase(A->in[0], WSP(WS_H), ssq, gw, NGW, lane);
    }
    { ArgsP A_ = get_args(); XcdBarrier b_; b_.bar = (unsigned*)(A_->ws + WS_BAR) + 4096 * 12; b_.x = xb_xcc_id(); b_.st = bar_st + 6; b_.G = (unsigned)G; xcd_barrier(b_, tid_now(wave_s) == 0); }
    if (get_args()->ws == nullptr) grid.sync();

#define SSQ(n) ((pg8::ssq_t*)(A->ws + WS_SSQ) + (size_t)(n) * NTOK)
#define XBCUR WSP((i & 1) ? WS_H2 : WS_H)
#define XBNXT WSP((i & 1) ? WS_H : WS_H2)
#define GRP (blk_now() & 7)
#define GC (blk_now() >> 3)
    const int GS = G >> 3;
#define GROUP_BAR() do { ArgsP A_ = get_args(); XcdBarrier b_; b_.bar = (unsigned*)(A_->ws + WS_BAR) + 4096 * GRP; b_.x = xb_xcc_id(); b_.st = bar_st; b_.G = (unsigned)GS; xcd_barrier(b_, tid_now(wave_s) == 0); } while (0)
#define PAIR_BAR() do { ArgsP A_ = get_args(); XcdBarrier b_; b_.bar = (unsigned*)(A_->ws + WS_BAR) + 4096 * (8 + (GRP >> 1)); b_.x = xb_xcc_id(); b_.st = bar_st + 2; b_.G = (unsigned)(2 * GS); xcd_barrier(b_, tid_now(wave_s) == 0); } while (0)
#define CONV_WORD(n) ((unsigned*)(A_->ws + WS_BAR) + 13 * 4096 + 64 * (n))
#define CONV_DONE(n) do { ArgsP A_ = get_args(); if (tid_now(wave_s) == 0) (void)xb_add(CONV_WORD(n), 1u); } while (0)
#define CONV_WAIT(n) do { ArgsP A_ = get_args(); if (tid_now(wave_s) == 0) { unsigned sp_ = 0u; while (xb_ld(CONV_WORD(n)) < (unsigned)(G / 2)) { __builtin_amdgcn_s_sleep(1); if (++sp_ > XB_SPIN_CAP) break; } \
        __builtin_amdgcn_fence(__ATOMIC_ACQUIRE, "agent"); asm volatile("s_waitcnt vmcnt(0)" ::: "memory"); } __syncthreads(); } while (0)
#define GIDS() IDS(); const int lgtid = GC * (NWAVES * 64) + tid_, lnthr = GS * (NWAVES * 64); (void)lgtid; (void)lnthr;
#pragma unroll 1
    for (int i = 0; i < DEPTH; ++i) {
        const int j = i >> 1;
        if ((i & 1) == 0) {
            {
                ArgsP A = get_args();
                pg8::GroupOrder S; S.init(0, 4096 / 256, GS, GC, GRP);
                pg8::Gemm g{XBCUR, WSP(WS_WQK) + (size_t)j * 4096 * D, NTOK, 4096, D, D, 0, 0};
                pg8::EpiBf16 E{WSP(WS_QK), 4096, A->in[4] + j * 3 * D, SSQ(3 * i), 8, QSCALE};
                pg8::gemm_phase<true>(lds, g, S, E, wave_s);
            }
            {
                ArgsP A = get_args();
                pg8::GroupOrder S; S.init(1, D / 256, GS, GC, GRP);
                pg8::Gemm g{WSP(WS_WV) + (size_t)j * D * D, XBCUR, D, NTOK, D, D, 0, 0};
                pg8::EpiVT E{WSP(WS_VT), A->in[4] + j * 3 * D + 4096, SSQ(3 * i)};
                pg8::gemm_phase<true>(lds, g, S, E, wave_s);
            }
            PAIR_BAR();
            { ArgsP A = get_args(); IDS(); attn_phase(WSP(WS_QK), WSP(WS_VT), A->in[6] + (size_t)j * NH * 15 * 31, WSP(WS_O), lds, GRP, GC, GS, tid_, wave, lane); }
            GROUP_BAR();
            {
                ArgsP A = get_args();
                pg8::GroupOrder S; S.init(0, D / 256, GS, GC, GRP);
                pg8::Gemm g{WSP(WS_O), WSP(WS_WO) + (size_t)j * D * D, NTOK, D, D, D, 0, 0};
                pg8::EpiResid E{XBCUR, SSQ(3 * i + 1)};
                pg8::gemm_phase<false>(lds, g, S, E, wave_s);
            }
            GROUP_BAR();
        } else {
            { ArgsP A = get_args(); GIDS(); poolmix_phase(XBCUR, SSQ(3 * i), A->in[7] + j * D, WSP(WS_O), 1024 * GRP, 1024, lgtid, lnthr, lds, tid_); }
            PAIR_BAR();
            {
                ArgsP A = get_args();
                pg8::GroupOrder S; S.init(0, D / 256, GS, GC, GRP);
                pg8::Gemm g{WSP(WS_O), WSP(WS_WPOOL) + (size_t)j * D * 512, NTOK, D, 512, D, 1, 512};
                pg8::EpiResid E{XBCUR, SSQ(3 * i + 1)};
                pg8::gemm_phase<false>(lds, g, S, E, wave_s);
            }
            GROUP_BAR();
        }
        if (i > 0) CONV_WAIT(i);
        {
            ArgsP A = get_args(); IDS();
            const pg8::ssq_t* sq = SSQ(3 * i + 1) + 256 * (4 * GRP + (GC & 3));
            if (tid_ < 256) ((LAS float*)(lds + 131072))[tid_] = pg8::rms_r(sq[tid_]);
            __syncthreads();
        }
        {
            ArgsP A = get_args();
            pg8::GroupOrder S; S.init(0, 2 * DFF / 256, GS, GC, GRP);
            pg8::Gemm g{XBCUR, WSP(WS_WGU) + (size_t)i * 2 * DFF * D, NTOK, 2 * DFF, D, D, 0, 0};
            pg8::EpiGU E{WSP(WS_ACT), (const LAS float*)(lds + 131072)};
            pg8::gemm_phase<true>(lds, g, S, E, wave_s);
        }
        {
            ArgsP A = get_args();
            pg8::GroupOrder S; S.init(0, D / 256, GS / 2, GC - GS / 2, GRP);
            pg8::Gemm g{WSP(WS_PB) + (size_t)i * NTOK * PLE, WSP(WS_WPP) + (size_t)i * D * PLE, NTOK, D, PLE, PLE, 0, 0};
            pg8::EpiBf16 E{WSP(WS_PP), D, nullptr, nullptr, 0, 1.f};
            pg8::gemm_phase<false>(lds, g, S, E, wave_s);
        }
        if (i + 1 < DEPTH && GC >= GS / 2) {
            ArgsP A = get_args(); IDS();
            LAS float* scr = (LAS float*)(lds + wave * 16384);
            int rot = 0;
            const int hgw = ((GC - GS / 2) * 8 + GRP) * NWAVES + wave, hNGW = (G / 2) * NWAVES, n = i + 1;
            conv_mat(A->in[13] + (size_t)n * DFF * D, DFF, D, WSP(WS_WD) + (size_t)n * D * DFF, 0, 0, 0, D, nullptr, nullptr, 1.f, 0, scr, rot, hgw, hNGW, lane);
            conv_mat(A->in[15] + (size_t)n * D * D, D, D, WSP(WS_WPG) + (size_t)n * D * D, 0, 0, 0, D, nullptr, A->in[14] + n * D, 1.f, 1, scr, rot, hgw, hNGW, lane);
            conv_mat(A->in[11] + (size_t)n * D * DFF, D, DFF, WSP(WS_WGU) + (size_t)n * 2 * DFF * D, 1, 0, 0, DFF, nullptr, A->in[10] + n * D, 1.f, 1, scr, rot, hgw, hNGW, lane);
        }
        GROUP_BAR();
        if (i + 1 < DEPTH && GC >= GS / 2) CONV_DONE(i + 1);
        if (i > 0) CONV_WAIT(i);
        {
            ArgsP A = get_args();
            pg8::GroupOrder S; S.init(0, D / 256, GS, GC, GRP);
            pg8::Gemm g{WSP(WS_ACT), WSP(WS_WD) + (size_t)i * D * DFF, NTOK, D, DFF, DFF, 0, 0};
            pg8::EpiResid E{XBCUR, SSQ(3 * i + 2)};
            pg8::gemm_phase<false>(lds, g, S, E, wave_s);
        }
        GROUP_BAR();
        if (i < DEPTH - 1) {
            {
                ArgsP A = get_args();
                pg8::GroupOrder S; S.init(0, D / 256, GS, GC, GRP);
                pg8::Gemm g{XBCUR, WSP(WS_WPG) + (size_t)i * D * D, NTOK, D, D, D, 0, 0};
                pg8::EpiPle E{XBCUR, XBNXT, WSP(WS_PP), A->in[16] + i * D, SSQ(3 * i + 2), SSQ(3 * i + 3)};
                pg8::gemm_phase<true>(lds, g, S, E, wave_s);
            }
            if ((i & 1) == 0) PAIR_BAR(); else GROUP_BAR();
        } else {
            ArgsP A = get_args();
            pg8::GroupOrder S; S.init(0, D / 256, GS, GC, GRP);
            pg8::Gemm g{XBCUR, WSP(WS_WPG) + (size_t)i * D * D, NTOK, D, D, D, 0, 0};
            XcdBarrier gb; gb.bar = (unsigned*)(A->ws + WS_BAR) + 4096 * GRP; gb.x = xb_xcc_id(); gb.st = bar_st; gb.G = (unsigned)GS;
            EpiPleFinal E{pg8::EpiPle{XBCUR, nullptr, WSP(WS_PP), A->in[16] + i * D, SSQ(3 * i + 2), SSQ(3 * i + 3)}, A->in[18], A->out, gb, wave_s};
            pg8::gemm_phase<true>(lds, g, S, E, wave_s);
        }
    }
}

extern "C" void kernel_launch(void* const* d_in, const int* in_sizes, int n_in, void* d_out, int out_size, void* d_ws, size_t ws_size, hipStream_t stream) {
    static int grid = 0;
    if (grid == 0) {
        if (n_in != 19 || out_size != NTOK * D || ws_size < WS_END) { fprintf(stderr, "kernel_launch: unexpected shapes (n_in %d, out %d, ws %zu < %zu)\n", n_in, out_size, ws_size, (size_t)WS_END); grid = -1; return; }
        int dev = 0, cus = 0, per_cu = 0;
        hipGetDevice(&dev);
        hipDeviceGetAttribute(&cus, hipDeviceAttributeMultiprocessorCount, dev);
        if (hipFuncSetAttribute((const void*)fwd_megakernel, hipFuncAttributeMaxDynamicSharedMemorySize, LDS_BYTES) != hipSuccess) { fprintf(stderr, "kernel_launch: hipFuncSetAttribute failed\n"); grid = -1; return; }
        if (hipOccupancyMaxActiveBlocksPerMultiprocessor(&per_cu, (const void*)fwd_megakernel, NWAVES * 64, LDS_BYTES) != hipSuccess || per_cu < 1) { fprintf(stderr, "kernel_launch: occupancy query failed (%d)\n", per_cu); (void)hipGetLastError(); per_cu = 1; }
        grid = cus * per_cu;
        if (grid % 8 != 0 || ((grid / 8) & (grid / 8 - 1)) != 0 || NH % (grid / 8) != 0 || (NTOK / 256) % 8 != 0) { fprintf(stderr, "kernel_launch: grid %d is not a multiple of 8\n", grid); grid = -1; return; }
    }
    if (grid < 0) return;
    Args a{};
    for (int i = 0; i < 19; ++i) a.in[i] = (const float*)d_in[i];
    a.out = (float*)d_out; a.ws = (unsigned char*)d_ws;
    if (hipMemsetAsync((unsigned char*)d_ws + WS_BAR, 0, (size_t)(13 * 4096 + 8 * 64) * 4, stream) != hipSuccess) { fprintf(stderr, "kernel_launch: hipMemsetAsync of the barrier words failed\n"); return; }
    void* kargs[] = {&a};
    hipError_t e = hipLaunchCooperativeKernel((const void*)fwd_megakernel, dim3(grid), dim3(NWAVES * 64), kargs, LDS_BYTES, stream);
    if (e != hipSuccess) fprintf(stderr, "cooperative launch failed: %s (grid %d)\n", hipGetErrorString(e), grid);
}
```

```cpp
#include <hip/hip_runtime.h>
#include <hip/hip_cooperative_groups.h>
#include <cstdio>
#include <cstdint>
namespace cg = cooperative_groups;

#define LAS __attribute__((address_space(3)))
typedef unsigned short bf16_t;
typedef short bf16x8 __attribute__((ext_vector_type(8)));
typedef float f32x4 __attribute__((ext_vector_type(4)));
typedef unsigned u32x4 __attribute__((ext_vector_type(4)));
typedef unsigned u32x2 __attribute__((ext_vector_type(2)));

constexpr int D = 2048, NTOK = 8192, SEQ = 2048, DFF = 5632, PLE = 256, NH = 64, HD = 32, DEPTH = 4;
constexpr float RMS_EPS = 1e-6f;
constexpr float LOG2E = 1.4426950408889634f;
constexpr float QSCALE = 0.17677669529663687f * LOG2E;

constexpr size_t MiB = 1u << 20;
constexpr size_t WS_WQK = 0;
constexpr size_t WS_WV = WS_WQK + 32 * MiB;
constexpr size_t WS_WO = WS_WV + 16 * MiB;
constexpr size_t WS_WPOOL = WS_WO + 16 * MiB;
constexpr size_t WS_WGU = WS_WPOOL + 4 * MiB;
constexpr size_t WS_WD = WS_WGU + 176 * MiB;
constexpr size_t WS_WPG = WS_WD + 88 * MiB;
constexpr size_t WS_WPP = WS_WPG + 32 * MiB;
constexpr size_t WS_PB = WS_WPP + 4 * MiB;
constexpr size_t WS_H = WS_PB + 16 * MiB;
constexpr size_t WS_QK = WS_H + 32 * MiB;
constexpr size_t WS_VT = WS_QK + 64 * MiB;
constexpr size_t WS_O = WS_VT + 32 * MiB;
constexpr size_t WS_PP = WS_O + 32 * MiB;
constexpr size_t WS_SSQ = WS_PP + 32 * MiB;
constexpr size_t WS_H2 = WS_SSQ + 1 * MiB;
constexpr size_t WS_BAR = WS_H2 + 32 * MiB;
constexpr size_t WS_ACT = WS_BAR + 1 * MiB;
constexpr size_t WS_END = WS_ACT + 88 * MiB;

constexpr int NWAVES = 8;
constexpr int LDS_BYTES = 147456;

__device__ __forceinline__ int blk_now() { int b = (int)blockIdx.x; asm volatile("" : "+s"(b)); return b; }
__device__ __forceinline__ int tid_now(int wave_s) { int l; asm volatile("v_mbcnt_lo_u32_b32 %0, -1, 0\n\tv_mbcnt_hi_u32_b32 %0, -1, %0" : "=v"(l)); return wave_s * 64 + l; }

namespace pg8 {
constexpr int BM = 256, BK = 64, HALF = 128, HTB = HALF * BK * 2, NXCD = 8, WGM = 8;

__host__ __device__ __forceinline__ int lds_byte(int r, int c) { const int st = (r >> 4) * 2 + (c >> 5), rr = r & 15, cc = c & 31, ob = rr * 64 + cc * 2; return st * 1024 + (ob ^ (((ob >> 9) & 1) << 5)); }
__host__ __device__ __forceinline__ void stage_rc(int b, int& R, int& C) { const int st = b / 1024, sb = b % 1024, swz = sb ^ (((sb >> 9) & 1) << 5); R = (st >> 1) * 16 + swz / 64; C = (st & 1) * 32 + (swz % 64) / 2; }
__host__ __device__ __forceinline__ int perm32(int rho) { const int n = rho >> 4, i = rho & 15; return 8 * (i >> 2) + 4 * n + (i & 3); }

struct Unit { int pm, pn; };
struct Gemm { const bf16_t* A; const bf16_t* Bt; int M, N, K, lda, agrp_shift, agrp_cols; };

struct StaticOrder {
    int nM, nN, nwg, G, c;
    __device__ void init(int M, int N, int G_, int c_) { asm volatile("" : "+s"(c_)); nM = M / BM; nN = N / BM; nwg = nM * nN; G = G_; c = c_; }
    __device__ bool next(int i, Unit& u) const {
        if (c < 0) return false;
        const long L = (long)i * G + c; if (L >= nwg) return false;
        int wgid = (int)L; { const int q = nwg / NXCD, r = nwg % NXCD, xcd = wgid % NXCD, off = wgid / NXCD; wgid = (xcd < r ? xcd * (q + 1) : r * (q + 1) + (xcd - r) * q) + off; }
        const int nig = WGM * nN, gid = wgid / nig, fm = gid * WGM, gsz = (nM - fm) < WGM ? (nM - fm) : WGM;
        u.pm = fm + ((wgid % nig) % gsz); u.pn = (wgid % nig) / gsz; return true;
    }
};

struct GroupOrder {
    int nwg, G, c, p0, mode;
    __device__ void init(int mode_, int nOther, int G_, int c_, int grp) { asm volatile("" : "+s"(c_)); mode = mode_; nwg = 4 * nOther; G = G_; c = c_; p0 = 4 * grp; }
    __device__ bool next(int i, Unit& u) const {
        if (c < 0) return false;
        const int L = i * G + c; if (L >= nwg) return false;
        if (mode == 0) { u.pm = p0 + (L & 3); u.pn = L >> 2; } else { u.pm = L & 7; u.pn = p0 + (L >> 3); }
        return true;
    }
};

__device__ __forceinline__ unsigned cvt_pk_bf16(float lo, float hi) { unsigned r; asm("v_cvt_pk_bf16_f32 %0, %1, %2" : "=v"(r) : "v"(lo), "v"(hi)); return r; }
__device__ __forceinline__ float bf_lo(unsigned w) { return __builtin_bit_cast(float, w << 16); }
__device__ __forceinline__ float bf_hi(unsigned w) { return __builtin_bit_cast(float, w & 0xffff0000u); }
typedef _Float16 h16x2 __attribute__((ext_vector_type(2)));
typedef _Float16 h16x8 __attribute__((ext_vector_type(8)));
#define X_BF16 1
__device__ __forceinline__ unsigned cvt_pk_f16(float lo, float hi) { if (X_BF16) return cvt_pk_bf16(lo, hi); const h16x2 v = {(_Float16)lo, (_Float16)hi}; return __builtin_bit_cast(unsigned, v); }
__device__ __forceinline__ float h_lo(unsigned w) { if (X_BF16) return bf_lo(w); return (float)__builtin_bit_cast(_Float16, (unsigned short)(w & 0xffffu)); }
__device__ __forceinline__ float h_hi(unsigned w) { if (X_BF16) return bf_hi(w); return (float)__builtin_bit_cast(_Float16, (unsigned short)(w >> 16)); }

typedef f32x4 Acc[2][2][4][2];

typedef unsigned ssq_t;
constexpr float SSQ_ONE = 128.f;
__device__ __forceinline__ ssq_t ssq_fix(float v) { return (ssq_t)(v * SSQ_ONE + 0.5f); }
__device__ __forceinline__ float rms_r(ssq_t ssq) { float eps = RMS_EPS; asm volatile("" : "+v"(eps));
    return 1.f / sqrtf(fmaf((float)ssq, 1.f / (SSQ_ONE * D), eps)); }
__device__ __forceinline__ void ssq_add(ssq_t* p, float v) { __hip_atomic_fetch_add(p, ssq_fix(v), __ATOMIC_RELAXED, __HIP_MEMORY_SCOPE_AGENT); }

struct EpiBf16 {
    bf16_t* O; int ldc; const float* bias; const ssq_t* ssq; int nscale_tiles; float bscale;
    __device__ __forceinline__ void operator()(const Acc& acc, const Unit& u, int wr, int wc, int fr, int fq) const {
        const int row0 = u.pm * BM + wr * 64 + fr, col0 = u.pn * BM + wc * 32 + 8 * fq;
        const float bs = (u.pn < nscale_tiles) ? bscale : 1.f;
        f32x4 bv[2][2];
#pragma unroll
        for (int bj = 0; bj < 2; ++bj)
#pragma unroll
            for (int n = 0; n < 2; ++n) bv[bj][n] = bias ? *(const f32x4*)(bias + col0 + bj * HALF + 4 * n) * bs : (f32x4){0.f, 0.f, 0.f, 0.f};
        ssq_t rrv[8];
#pragma unroll
        for (int q = 0; q < 8; ++q) rrv[q] = ssq ? ssq[row0 + (q >> 2) * HALF + (q & 3) * 16] : 0u;
#pragma unroll
        for (int ai = 0; ai < 2; ++ai)
#pragma unroll
            for (int m = 0; m < 4; ++m) {
                const int row = row0 + ai * HALF + m * 16;
                const float rr = ssq ? rms_r(rrv[ai * 4 + m]) : 1.f;
                bf16_t* rowp = O + (size_t)row * ldc + col0;
#pragma unroll
                for (int bj = 0; bj < 2; ++bj) {
                    const f32x4 v0 = acc[ai][bj][m][0] * rr + bv[bj][0], v1 = acc[ai][bj][m][1] * rr + bv[bj][1];
                    u32x4 w; w.x = cvt_pk_bf16(v0[0], v0[1]); w.y = cvt_pk_bf16(v0[2], v0[3]); w.z = cvt_pk_bf16(v1[0], v1[1]); w.w = cvt_pk_bf16(v1[2], v1[3]);
                    *(u32x4*)(rowp + bj * HALF) = w;
                }
            }
    }
};

struct EpiVT {
    bf16_t* O; const float* bias; const ssq_t* ssq;
    __device__ __forceinline__ void operator()(const Acc& acc, const Unit& u, int wr, int wc, int fr, int fq) const {
        const int row0 = u.pm * BM + wr * 64 + fr, col0 = u.pn * BM + wc * 32 + 8 * fq;
        f32x4 rv[2][2];
#pragma unroll
        for (int bj = 0; bj < 2; ++bj)
#pragma unroll
            for (int n = 0; n < 2; ++n) { const ssq_t* s = ssq + col0 + bj * HALF + 4 * n; rv[bj][n] = (f32x4){rms_r(s[0]), rms_r(s[1]), rms_r(s[2]), rms_r(s[3])}; }
        float brv[8];
#pragma unroll
        for (int q = 0; q < 8; ++q) brv[q] = bias[row0 + (q >> 2) * HALF + (q & 3) * 16];
#pragma unroll
        for (int ai = 0; ai < 2; ++ai)
#pragma unroll
            for (int m = 0; m < 4; ++m) {
                const int row = row0 + ai * HALF + m * 16;
                const float br = brv[ai * 4 + m];
                bf16_t* rowp = O + (size_t)row * NTOK + col0;
#pragma unroll
                for (int bj = 0; bj < 2; ++bj) {
                    const f32x4 v0 = acc[ai][bj][m][0] * rv[bj][0] + br, v1 = acc[ai][bj][m][1] * rv[bj][1] + br;
                    u32x4 w; w.x = cvt_pk_bf16(v0[0], v0[1]); w.y = cvt_pk_bf16(v0[2], v0[3]); w.z = cvt_pk_bf16(v1[0], v1[1]); w.w = cvt_pk_bf16(v1[2], v1[3]);
                    *(u32x4*)(rowp + bj * HALF) = w;
                }
            }
    }
};

struct EpiResid {
    bf16_t* x16; ssq_t* ssq_out;
    __device__ __forceinline__ void operator()(Acc& acc, const Unit& u, int wr, int wc, int fr, int fq) const {
        const int row0 = u.pm * BM + wr * 64 + fr, col0 = u.pn * BM + wc * 32 + 8 * fq;
        const size_t base = (size_t)row0 * D + col0;
        u32x4 xv[4][2];
        float ssv[8];
#define ER_LOAD(ai) _Pragma("unroll") for (int m = 0; m < 4; ++m) _Pragma("unroll") for (int bj = 0; bj < 2; ++bj) xv[m][bj] = *(const u32x4*)(x16 + base + (size_t)((ai) * HALF + m * 16) * D + bj * HALF);
#define ER_ADD(ai) _Pragma("unroll") for (int m = 0; m < 4; ++m) _Pragma("unroll") for (int bj = 0; bj < 2; ++bj) { const u32x4 w = xv[m][bj]; \
            acc[ai][bj][m][0] += (f32x4){h_lo(w.x), h_hi(w.x), h_lo(w.y), h_hi(w.y)}; acc[ai][bj][m][1] += (f32x4){h_lo(w.z), h_hi(w.z), h_lo(w.w), h_hi(w.w)}; }
#define ER_STORE(ai) _Pragma("unroll") for (int m = 0; m < 4; ++m) { float ss = 0.f; _Pragma("unroll") for (int bj = 0; bj < 2; ++bj) { \
            const f32x4 x0 = acc[ai][bj][m][0], x1 = acc[ai][bj][m][1]; \
            u32x4 w; w.x = cvt_pk_f16(x0[0], x0[1]); w.y = cvt_pk_f16(x0[2], x0[3]); w.z = cvt_pk_f16(x1[0], x1[1]); w.w = cvt_pk_f16(x1[2], x1[3]); \
            *(u32x4*)(x16 + base + (size_t)((ai) * HALF + m * 16) * D + bj * HALF) = w; \
            ss += (x0[0] * x0[0] + x0[1] * x0[1]) + (x0[2] * x0[2] + x0[3] * x0[3]) + (x1[0] * x1[0] + x1[1] * x1[1]) + (x1[2] * x1[2] + x1[3] * x1[3]); } \
            ssv[(ai) * 4 + m] = ss; }
        ER_LOAD(0); ER_ADD(0); ER_LOAD(1); ER_STORE(0); ER_ADD(1); ER_STORE(1);
#undef ER_LOAD
#undef ER_ADD
#undef ER_STORE
#pragma unroll
        for (int q = 0; q < 8; ++q) { ssv[q] += __shfl_xor(ssv[q], 16); }
#pragma unroll
        for (int q = 0; q < 8; ++q) { ssv[q] += __shfl_xor(ssv[q], 32); }
        if (fq == 0) {
#pragma unroll
            for (int q = 0; q < 8; ++q) ssq_add(ssq_out + row0 + (q >> 2) * HALF + (q & 3) * 16, ssv[q]);
        }
    }
};

struct EpiGU {
    bf16_t* O; const LAS float* lr;
    __device__ __forceinline__ void operator()(const Acc& acc, const Unit& u, int wr, int wc, int fr, int fq) const {
        const int row0 = u.pm * BM + wr * 64 + fr, col0 = u.pn * HALF + wc * 32 + 8 * fq;
        float rrv[8];
#pragma unroll
        for (int q = 0; q < 8; ++q) rrv[q] = lr[wr * 64 + fr + (q >> 2) * HALF + (q & 3) * 16];
#pragma unroll
        for (int ai = 0; ai < 2; ++ai)
#pragma unroll
            for (int m = 0; m < 4; ++m) {
                const int row = row0 + ai * HALF + m * 16;
                const float rr = rrv[ai * 4 + m];
                float r[8];
#pragma unroll
                for (int n = 0; n < 2; ++n)
#pragma unroll
                    for (int j = 0; j < 4; ++j) {
                        const float g = acc[ai][0][m][n][j] * rr, up = acc[ai][1][m][n][j] * rr;
                        r[n * 4 + j] = g * __builtin_amdgcn_rcpf(1.f + __builtin_amdgcn_exp2f(-g * LOG2E)) * up;
                    }
                u32x4 w; w.x = cvt_pk_bf16(r[0], r[1]); w.y = cvt_pk_bf16(r[2], r[3]); w.z = cvt_pk_bf16(r[4], r[5]); w.w = cvt_pk_bf16(r[6], r[7]);
                *(u32x4*)(O + (size_t)row * DFF + col0) = w;
            }
    }
};

struct EpiPle {
    const bf16_t* xin16; bf16_t* xout16; const bf16_t* pp; const float* bias; const ssq_t* ssq_in; ssq_t* ssq_out;
    __device__ __forceinline__ void operator()(Acc& acc, const Unit& u, int wr, int wc, int fr, int fq) const {
        const int row0 = u.pm * BM + wr * 64 + fr, col0 = u.pn * BM + wc * 32 + 8 * fq;
        const size_t base = (size_t)row0 * D + col0;
        f32x4 bv[2][2];
#pragma unroll
        for (int bj = 0; bj < 2; ++bj)
#pragma unroll
            for (int n = 0; n < 2; ++n) bv[bj][n] = *(const f32x4*)(bias + col0 + bj * HALF + 4 * n);
        ssq_t rrv[8]; float ssv[8];
#pragma unroll
        for (int q = 0; q < 8; ++q) rrv[q] = ssq_in[row0 + (q >> 2) * HALF + (q & 3) * 16];
        u32x4 xv[2][2], pv[2][2];
#define EP_LOAD(ai, mp) _Pragma("unroll") for (int mm = 0; mm < 2; ++mm) _Pragma("unroll") for (int bj = 0; bj < 2; ++bj) { const size_t off = base + (size_t)((ai) * HALF + (2 * (mp) + mm) * 16) * D + bj * HALF; \
            xv[mm][bj] = *(const u32x4*)(xin16 + off); pv[mm][bj] = *(const u32x4*)(pp + off); }
#define EP_ADD(ai, mp) _Pragma("unroll") for (int mm = 0; mm < 2; ++mm) { const int m = 2 * (mp) + mm; const float rr = rms_r(rrv[(ai) * 4 + m]); _Pragma("unroll") for (int bj = 0; bj < 2; ++bj) { \
            const u32x4 pw = pv[mm][bj], xw = xv[mm][bj]; \
            const f32x4 p0 = {bf_lo(pw.x), bf_hi(pw.x), bf_lo(pw.y), bf_hi(pw.y)}, p1 = {bf_lo(pw.z), bf_hi(pw.z), bf_lo(pw.w), bf_hi(pw.w)}; \
            const f32x4 a0 = acc[ai][bj][m][0] * rr + bv[bj][0], a1 = acc[ai][bj][m][1] * rr + bv[bj][1]; \
            f32x4 x0 = {h_lo(xw.x), h_hi(xw.x), h_lo(xw.y), h_hi(xw.y)}, x1 = {h_lo(xw.z), h_hi(xw.z), h_lo(xw.w), h_hi(xw.w)}; \
            _Pragma("unroll") for (int j = 0; j < 4; ++j) { \
                x0[j] += p0[j] * __builtin_amdgcn_rcpf(1.f + __builtin_amdgcn_exp2f(-a0[j] * LOG2E)); \
                x1[j] += p1[j] * __builtin_amdgcn_rcpf(1.f + __builtin_amdgcn_exp2f(-a1[j] * LOG2E)); } \
            acc[ai][bj][m][0] = x0; acc[ai][bj][m][1] = x1; } }
#define EP_STORE(ai, mp) _Pragma("unroll") for (int mm = 0; mm < 2; ++mm) { const int m = 2 * (mp) + mm; float ss = 0.f; _Pragma("unroll") for (int bj = 0; bj < 2; ++bj) { \
            const f32x4 x0 = acc[ai][bj][m][0], x1 = acc[ai][bj][m][1]; \
            u32x4 w; w.x = cvt_pk_f16(x0[0], x0[1]); w.y = cvt_pk_f16(x0[2], x0[3]); w.z = cvt_pk_f16(x1[0], x1[1]); w.w = cvt_pk_f16(x1[2], x1[3]); \
            if (xout16) *(u32x4*)(xout16 + base + (size_t)((ai) * HALF + m * 16) * D + bj * HALF) = w; \
            ss += (x0[0] * x0[0] + x0[1] * x0[1]) + (x0[2] * x0[2] + x0[3] * x0[3]) + (x1[0] * x1[0] + x1[1] * x1[1]) + (x1[2] * x1[2] + x1[3] * x1[3]); } \
            ssv[(ai) * 4 + m] = ss; }
        EP_LOAD(0, 0); EP_ADD(0, 0); EP_LOAD(0, 1); EP_STORE(0, 0); EP_ADD(0, 1); EP_LOAD(1, 0); EP_STORE(0, 1); EP_ADD(1, 0); EP_LOAD(1, 1); EP_STORE(1, 0); EP_ADD(1, 1); EP_STORE(1, 1);
#undef EP_LOAD
#undef EP_ADD
#undef EP_STORE
#pragma unroll
        for (int q = 0; q < 8; ++q) { ssv[q] += __shfl_xor(ssv[q], 16); }
#pragma unroll
        for (int q = 0; q < 8; ++q) { ssv[q] += __shfl_xor(ssv[q], 32); }
        if (fq == 0) {
#pragma unroll
            for (int q = 0; q < 8; ++q) ssq_add(ssq_out + row0 + (q >> 2) * HALF + (q & 3) * 16, ssv[q]);
        }
    }
};

template <bool F16, class Sched, class Epi>
__device__ __forceinline__ void gemm_phase(LAS unsigned char* lds, const Gemm g, const Sched& S, const Epi& E, int wave_s) {
    const int tid = tid_now(wave_s);
    const int wid = __builtin_amdgcn_readfirstlane(tid >> 6), lane = tid & 63, wr = wid >> 2, wc = wid & 3, fr = lane & 15, fq = lane >> 4;
    const int K = g.K, nt = K / BK, lda = g.lda;
    unsigned voffA[2], voffB[2];
#pragma unroll
    for (int i = 0; i < 2; ++i) { int R, C; stage_rc(tid * 16 + i * 8192, R, C); const int Rb = (R & ~31) + perm32(R & 31);
        voffA[i] = (unsigned)(R * lda + C) * 2u; voffB[i] = (unsigned)(Rb * K + C) * 2u; }
    const size_t kstep = (size_t)(BK * 2);
    const size_t hstepA = (size_t)HALF * lda * 2, hstepB = (size_t)HALF * K * 2;
    const size_t tstepA = 2 * hstepA, tstepB = 2 * hstepB;
    const unsigned ldsw = (unsigned)wid * 1024u;
    const int aoff = lds_byte(wr * 64 + fr, fq * 8), boff = lds_byte(wc * 32 + fr, fq * 8);
#define PG8_SA(b, h) (((b) * 2 + (h)) * HTB)
#define PG8_SB(b, h) ((4 + (b) * 2 + (h)) * HTB)
#define PG8_STAGE(bufoff, gbase, voff) do { _Pragma("unroll") for (int _i = 0; _i < 2; ++_i) \
        __builtin_amdgcn_global_load_lds((const unsigned*)((const char*)(gbase) + (voff)[_i]), (LAS unsigned*)(lds + (bufoff) + ldsw + _i * 8192), 16, 0, 0); } while (0)
#define PG8_LDA(dst, b, h) do { _Pragma("unroll") for (int m = 0; m < 4; ++m) _Pragma("unroll") for (int k = 0; k < 2; ++k) dst[m][k] = *(const LAS bf16x8*)(lds + PG8_SA(b, h) + aoff + m * 2048 + k * 1024); } while (0)
#define PG8_LDB(dst, b, h) do { _Pragma("unroll") for (int n = 0; n < 2; ++n) _Pragma("unroll") for (int k = 0; k < 2; ++k) dst[n][k] = *(const LAS bf16x8*)(lds + PG8_SB(b, h) + boff + n * 2048 + k * 1024); } while (0)
#define PG8_MMA(ai, bj, At, Bt) do { __builtin_amdgcn_s_setprio(1); _Pragma("unroll") for (int m = 0; m < 4; ++m) _Pragma("unroll") for (int n = 0; n < 2; ++n) _Pragma("unroll") for (int k = 0; k < 2; ++k) \
        acc[ai][bj][m][n] = (F16 && !X_BF16) ? __builtin_amdgcn_mfma_f32_16x16x32_f16(__builtin_bit_cast(h16x8, Bt[n][k]), __builtin_bit_cast(h16x8, At[m][k]), acc[ai][bj][m][n], 0, 0, 0) \
                                : __builtin_amdgcn_mfma_f32_16x16x32_bf16(Bt[n][k], At[m][k], acc[ai][bj][m][n], 0, 0, 0); __builtin_amdgcn_s_setprio(0); } while (0)
#define PG8_WAIT_V(n) asm volatile("s_waitcnt vmcnt(" #n ")" ::: "memory")
#define PG8_WAIT_L(n) asm volatile("s_waitcnt lgkmcnt(" #n ")" ::: "memory")
#define PG8_BAR __builtin_amdgcn_s_barrier()
#define PG8_SCHED __builtin_amdgcn_sched_barrier(0)
#define PG8_AOFF(u) ((size_t)(u).pm * tstepA + (size_t)(((u).pn >> g.agrp_shift) * g.agrp_cols) * 2)
    Unit cur, nxt; int ui = 0;
    if (!S.next(0, cur)) return;
    f32x4 acc[2][2][4][2];
#pragma unroll
    for (int a = 0; a < 2; ++a)
#pragma unroll
        for (int b = 0; b < 2; ++b)
#pragma unroll
            for (int m = 0; m < 4; ++m)
#pragma unroll
                for (int n = 0; n < 2; ++n) acc[a][b][m][n] = (f32x4){0.f, 0.f, 0.f, 0.f};
    bf16x8 At[4][2], B0[2][2], B1[2][2];
    const char* cA = (const char*)g.A + PG8_AOFF(cur); const char* cB = (const char*)g.Bt + (size_t)cur.pn * tstepB;
    PG8_STAGE(PG8_SB(0, 0), cB, voffB); PG8_STAGE(PG8_SB(0, 1), cB + hstepB, voffB); PG8_STAGE(PG8_SA(0, 0), cA, voffA); PG8_STAGE(PG8_SA(0, 1), cA + hstepA, voffA);
    if (wr == 1) PG8_BAR;
    PG8_WAIT_V(2); PG8_BAR;
    PG8_STAGE(PG8_SB(1, 0), cB + kstep, voffB); PG8_STAGE(PG8_SA(1, 0), cA + kstep, voffA); PG8_STAGE(PG8_SB(1, 1), cB + hstepB + kstep, voffB);
    PG8_WAIT_V(6); PG8_BAR;
    for (;;) {
        const bool has_next = S.next(ui + 1, nxt);
        const char* nA = has_next ? (const char*)g.A + PG8_AOFF(nxt) : cA + (size_t)(nt - 2) * kstep; const char* nB = has_next ? (const char*)g.Bt + (size_t)nxt.pn * tstepB : cB + (size_t)(nt - 2) * kstep;
        for (int t = 0; t < nt; t += 2) {
            const bool last = (t == nt - 2);
            const char* a1 = cA + (size_t)(t + 1) * kstep;
            const char* a2 = last ? nA : cA + (size_t)(t + 2) * kstep; const char* b2 = last ? nB : cB + (size_t)(t + 2) * kstep;
            const char* a3 = a2 + kstep; const char* b3 = b2 + kstep;
            PG8_LDB(B0, 0, 0); PG8_LDB(B1, 0, 1); PG8_SCHED; PG8_LDA(At, 0, 0); PG8_STAGE(PG8_SA(1, 1), a1 + hstepA, voffA);
            PG8_WAIT_V(8); PG8_WAIT_L(0); PG8_BAR; PG8_MMA(0, 0, At, B0); PG8_MMA(0, 1, At, B1); PG8_BAR; PG8_SCHED;
            PG8_LDA(At, 0, 1); PG8_STAGE(PG8_SB(0, 0), b2, voffB); PG8_STAGE(PG8_SB(0, 1), b2 + hstepB, voffB); PG8_STAGE(PG8_SA(0, 0), a2, voffA);
            PG8_WAIT_V(8); PG8_WAIT_L(0); PG8_BAR; PG8_MMA(1, 0, At, B0); PG8_MMA(1, 1, At, B1); PG8_BAR; PG8_SCHED;
            PG8_LDB(B0, 1, 0); PG8_LDB(B1, 1, 1); PG8_SCHED; PG8_LDA(At, 1, 0); PG8_STAGE(PG8_SA(0, 1), a2 + hstepA, voffA);
            PG8_WAIT_V(8); PG8_WAIT_L(0); PG8_BAR; PG8_MMA(0, 0, At, B0); PG8_MMA(0, 1, At, B1); PG8_BAR; PG8_SCHED;
            PG8_LDA(At, 1, 1); PG8_STAGE(PG8_SB(1, 0), b3, voffB); PG8_STAGE(PG8_SB(1, 1), b3 + hstepB, voffB); PG8_STAGE(PG8_SA(1, 0), a3, voffA);
            PG8_WAIT_V(8); PG8_WAIT_L(0); PG8_BAR; PG8_MMA(1, 0, At, B0); PG8_MMA(1, 1, At, B1); PG8_BAR; PG8_SCHED;
        }
        if (wr == 0) PG8_BAR;
        E(acc, cur, wr, wc, fr, fq);
        if (!has_next) break;
#pragma unroll
        for (int a = 0; a < 2; ++a)
#pragma unroll
            for (int b = 0; b < 2; ++b)
#pragma unroll
                for (int m = 0; m < 4; ++m)
#pragma unroll
                    for (int n = 0; n < 2; ++n) acc[a][b][m][n] = (f32x4){0.f, 0.f, 0.f, 0.f};
        cur = nxt; cA = nA; cB = nB; ++ui;
        if (wr == 1) PG8_BAR;
    }
    PG8_WAIT_V(0);
    PG8_BAR;
#undef PG8_SA
#undef PG8_SB
#undef PG8_STAGE
#undef PG8_LDA
#undef PG8_LDB
#undef PG8_MMA
#undef PG8_WAIT_V
#undef PG8_WAIT_L
#undef PG8_BAR
#undef PG8_SCHED
#undef PG8_AOFF
}
}

using pg8::cvt_pk_bf16;

__device__ __forceinline__ float wave_sum(float v) {
#pragma unroll
    for (int o = 1; o < 64; o <<= 1) v += __shfl_xor(v, o);
    return v;
}

__device__ __forceinline__ void conv_item(const float* __restrict__ W, int N, bf16_t* __restrict__ WT, int ldk, int mode, int row_off, int n_lo, int nblk,
                                          const float* __restrict__ sn, const float* __restrict__ gk, float sc, int f16, LAS float* scr, int item, int lane) {
    const int kb = item / nblk, nb = item % nblk, k0 = 64 * kb, n0 = n_lo + 32 * nb;
    const float s = sc * (sn ? sn[n0 + (lane & 31)] : 1.f);
    const float* wp = W + (size_t)(k0 + (lane >> 5)) * N + n0 + (lane & 31);
    float v[32];
#pragma unroll
    for (int i = 0; i < 32; ++i) v[i] = __builtin_nontemporal_load(wp + (size_t)(2 * i) * N);
#pragma unroll
    for (int i = 0; i < 32; ++i) scr[(2 * i + (lane >> 5)) * 33 + (lane & 31)] = v[i] * s;
    asm volatile("s_waitcnt lgkmcnt(0)" ::: "memory");
    const int c = lane & 7;
    f32x4 g0 = {1.f, 1.f, 1.f, 1.f}, g1 = g0;
    if (gk) { g0 = *(const f32x4*)(gk + k0 + 8 * c); g1 = *(const f32x4*)(gk + k0 + 8 * c + 4); }
    const int nn0 = n0 - n_lo;
    const int drow0 = (mode == 0) ? row_off + nn0 : 256 * (nn0 >> 7) + 128 * (mode - 1) + (nn0 & 127);
#pragma unroll
    for (int j = 0; j < 4; ++j) { const int n = (lane >> 3) + 8 * j; const LAS float* sp = scr + (8 * c) * 33 + n;
        const float e0 = sp[0 * 33] * g0[0], e1 = sp[1 * 33] * g0[1], e2 = sp[2 * 33] * g0[2], e3 = sp[3 * 33] * g0[3], e4 = sp[4 * 33] * g1[0], e5 = sp[5 * 33] * g1[1], e6 = sp[6 * 33] * g1[2], e7 = sp[7 * 33] * g1[3];
        u32x4 o;
        if (f16) { o.x = pg8::cvt_pk_f16(e0, e1); o.y = pg8::cvt_pk_f16(e2, e3); o.z = pg8::cvt_pk_f16(e4, e5); o.w = pg8::cvt_pk_f16(e6, e7); }
        else { o.x = cvt_pk_bf16(e0, e1); o.y = cvt_pk_bf16(e2, e3); o.z = cvt_pk_bf16(e4, e5); o.w = cvt_pk_bf16(e6, e7); }
        *(u32x4*)(WT + (size_t)(drow0 + n) * ldk + k0 + 8 * c) = o; }
    asm volatile("s_waitcnt lgkmcnt(0)" ::: "memory");
}
__device__ __forceinline__ void conv_mat(const float* W, int K, int N, bf16_t* WT, int mode, int row_off, int n_lo, int n_hi, const float* sn, const float* gk, float sc, int f16,
                                         LAS float* scr, int& rot, int gw, int NGW, int lane) {
    const int nblk = (n_hi - n_lo) >> 5, nitems = (K >> 6) * nblk;
    int it = gw - rot; if (it < 0) it += NGW;
    for (; it < nitems; it += NGW) conv_item(W, N, WT, K, mode, row_off, n_lo, nblk, sn, gk, sc, f16, scr, it, lane);
    rot = (rot + nitems) % NGW;
}

__device__ __forceinline__ void xb_ssq_phase(const float* __restrict__ x, bf16_t* __restrict__ xb, pg8::ssq_t* __restrict__ ssq, int gw, int NGW, int lane) {
    for (int m = gw; m < NTOK; m += NGW) {
        const f32x4* xr = (const f32x4*)(x + (size_t)m * D) + lane;
        f32x4 v[8]; float s = 0.f;
#pragma unroll
        for (int j = 0; j < 8; ++j) { v[j] = xr[64 * j]; s += (v[j].x * v[j].x + v[j].y * v[j].y) + (v[j].z * v[j].z + v[j].w * v[j].w); }
        s = wave_sum(s);
        u32x2* o8 = (u32x2*)(xb + (size_t)m * D) + lane;
#pragma unroll
        for (int j = 0; j < 8; ++j) { u32x2 w; w.x = pg8::cvt_pk_f16(v[j].x, v[j].y); w.y = pg8::cvt_pk_f16(v[j].z, v[j].w); o8[64 * j] = w; }
        if (lane == 0) ssq[m] = pg8::ssq_fix(s);
    }
}
__device__ __forceinline__ void final_norm_phase(const bf16_t* __restrict__ x16, const pg8::ssq_t* __restrict__ ssq, const float* __restrict__ g, float* __restrict__ out, int row_lo, int nrows, int gtid, int nthr) {
    for (int idx = row_lo * (D / 8) + gtid; idx < (row_lo + nrows) * (D / 8); idx += nthr) {
        const int row = idx >> 8, c8 = (idx & 255) * 8;
        const float r = pg8::rms_r(ssq[row]);
        const u32x4 w = ((const u32x4*)x16)[idx];
        const f32x4 g0 = *(const f32x4*)(g + c8), g1 = *(const f32x4*)(g + c8 + 4);
        f32x4* o = (f32x4*)(out + (size_t)row * D + c8);
        o[0] = (f32x4){pg8::h_lo(w.x), pg8::h_hi(w.x), pg8::h_lo(w.y), pg8::h_hi(w.y)} * r * g0;
        o[1] = (f32x4){pg8::h_lo(w.z), pg8::h_hi(w.z), pg8::h_lo(w.w), pg8::h_hi(w.w)} * r * g1;
    }
}

__device__ __forceinline__ void poolmix_phase(const bf16_t* __restrict__ XB, const pg8::ssq_t* __restrict__ ssq, const float* __restrict__ g, bf16_t* __restrict__ MX, int row_lo, int nrows, int gtid, int nthr, LAS unsigned char* lds, int tid) {
    LAS float* rl = (LAS float*)lds;
    for (int q = tid; q < nrows + 16; q += NWAVES * 64) rl[q] = pg8::rms_r(ssq[min(max(row_lo - 8 + q, 0), NTOK - 1)]);
    __syncthreads();
#define PM_V(tt, sgn) do { if ((unsigned)(tt) < (unsigned)SEQ) { const u32x4 v_ = *(const u32x4*)(base + (size_t)(tt) * D); const float r_ = (sgn) * sb[tt]; \
        a[0] += pg8::h_lo(v_.x) * r_; a[1] += pg8::h_hi(v_.x) * r_; a[2] += pg8::h_lo(v_.y) * r_; a[3] += pg8::h_hi(v_.y) * r_; \
        a[4] += pg8::h_lo(v_.z) * r_; a[5] += pg8::h_hi(v_.z) * r_; a[6] += pg8::h_lo(v_.w) * r_; a[7] += pg8::h_hi(v_.w) * r_; } } while (0)
    for (int item = gtid; item < (nrows >> 4) * (D / 8); item += nthr) {
        const int ch = (item & 255) * 8, seg = item >> 8, grp = ch >> 9, w = 2 << grp, hw = w >> 1;
        const int tg0 = row_lo + seg * 16, t0 = tg0 & (SEQ - 1), seq0 = tg0 - t0;
        const bf16_t* base = XB + (size_t)seq0 * D + ch;
        const LAS float* sb = rl + (seq0 - (row_lo - 8));
        const f32x4 g0 = *(const f32x4*)(g + ch), g1 = *(const f32x4*)(g + ch + 4);
        float a[8];
#pragma unroll
        for (int e = 0; e < 8; ++e) a[e] = 0.f;
        for (int tt = t0 - hw; tt < t0 + w - hw; ++tt) PM_V(tt, 1.f);
#pragma unroll 1
        for (int k = 0; k < 16; ++k) {
            const int t = t0 + k;
            const int lo = max(t - hw, 0), hi = min(t + w - hw, SEQ);
            const float inv = 1.f / (float)(hi - lo), rs = sb[t];
            const u32x4 sv = *(const u32x4*)(base + (size_t)t * D);
            u32x4 o;
            o.x = cvt_pk_bf16((a[0] * inv - pg8::h_lo(sv.x) * rs) * g0[0], (a[1] * inv - pg8::h_hi(sv.x) * rs) * g0[1]);
            o.y = cvt_pk_bf16((a[2] * inv - pg8::h_lo(sv.y) * rs) * g0[2], (a[3] * inv - pg8::h_hi(sv.y) * rs) * g0[3]);
            o.z = cvt_pk_bf16((a[4] * inv - pg8::h_lo(sv.z) * rs) * g1[0], (a[5] * inv - pg8::h_hi(sv.z) * rs) * g1[1]);
            o.w = cvt_pk_bf16((a[6] * inv - pg8::h_lo(sv.w) * rs) * g1[2], (a[7] * inv - pg8::h_hi(sv.w) * rs) * g1[3]);
            *(u32x4*)(MX + (size_t)(tg0 + k) * D + ch) = o;
            PM_V(t + w - hw, 1.f); PM_V(t - hw, -1.f);
        }
    }
#undef PM_V
}

__device__ __forceinline__ f32x4 mfma16(bf16x8 a, bf16x8 b, f32x4 c) { return __builtin_amdgcn_mfma_f32_16x16x32_bf16(a, b, c, 0, 0, 0); }

constexpr int AT_K = 0, AT_V = 61440, AT_B = 122880, AT_BCOPY = 3840 + 64;

__device__ __forceinline__ void attn_qblock(const bf16x8 qf, bf16_t* __restrict__ O, LAS unsigned char* lds,
                                            size_t tok0, int r, int r_start, int il0, int j, int h, int ql, int fq) {
    const int cs = (j == 0) ? 0 : (j == 1) ? 8 : (j == 2) ? 24 : 32;
    const int qc = 16 * j + ql;
    const int c_start = min(max(qc - 8, 0), 48);
    const size_t qtok = tok0 + (size_t)r * 64 + qc;
    const int t = cs + 8 * (ql >> 2) + (ql & 3);
    const LAS unsigned char* kp = lds + AT_K + (il0 * 64 + t) * 64 + ((fq ^ ((t >> 3) & 3)) * 16);
    const int x0 = cs + 8 * fq - qc + 31;
    const LAS unsigned char* bp = lds + AT_B + (x0 & 3) * AT_BCOPY + ((r_start - r + 7) * 64 + (x0 & ~3)) * 4;
    const LAS unsigned char* vp = lds + AT_V + (il0 * 32 + ql) * 128 + ((((cs >> 3) + fq) ^ ((ql >> 1) & 7)) * 16);
    const int kc0 = cs + 8 * fq - c_start;
    f32x4 sx[8], sy[8];
#pragma unroll
    for (int i = 0; i < 8; ++i) {
        const bf16x8 kx = *(const LAS bf16x8*)(kp + i * 4096), ky = *(const LAS bf16x8*)(kp + i * 4096 + 256);
        const f32x4 z = {0.f, 0.f, 0.f, 0.f};
        sx[i] = mfma16(kx, qf, z); sy[i] = mfma16(ky, qf, z);
        if (i == 3) __builtin_amdgcn_sched_barrier(0);
    }
    __builtin_amdgcn_sched_barrier(0);
#pragma unroll
    for (int i = 0; i < 8; ++i) {
        const f32x4 b0 = *(const LAS f32x4*)(bp + i * 256), b1 = *(const LAS f32x4*)(bp + i * 256 + 16);
#pragma unroll
        for (int e = 0; e < 4; ++e) {
            sx[i][e] = ((unsigned)(kc0 + e) < 16u) ? sx[i][e] + b0[e] : -INFINITY;
            sy[i][e] = ((unsigned)(kc0 + e + 4) < 16u) ? sy[i][e] + b1[e] : -INFINITY;
        }
    }
    __builtin_amdgcn_sched_barrier(0);
    const bf16x8 ones = {(short)0x3F80, (short)0x3F80, (short)0x3F80, (short)0x3F80, (short)0x3F80, (short)0x3F80, (short)0x3F80, (short)0x3F80};
    f32x4 o0 = {0.f, 0.f, 0.f, 0.f}, o1 = {0.f, 0.f, 0.f, 0.f}, ol = {0.f, 0.f, 0.f, 0.f};
#pragma unroll
    for (int i = 0; i < 8; ++i) {
        float p[8];
#pragma unroll
        for (int e = 0; e < 4; ++e) { p[e] = __builtin_amdgcn_exp2f(sx[i][e]); p[e + 4] = __builtin_amdgcn_exp2f(sy[i][e]); }
        u32x4 pw; pw.x = cvt_pk_bf16(p[0], p[1]); pw.y = cvt_pk_bf16(p[2], p[3]); pw.z = cvt_pk_bf16(p[4], p[5]); pw.w = cvt_pk_bf16(p[6], p[7]);
        const bf16x8 pf = __builtin_bit_cast(bf16x8, pw);
        const bf16x8 v0 = *(const LAS bf16x8*)(vp + i * 4096), v1 = *(const LAS bf16x8*)(vp + i * 4096 + 2048);
        o0 = mfma16(v0, pf, o0); o1 = mfma16(v1, pf, o1); ol = mfma16(ones, pf, ol);
    }
    const float inv = 1.f / ol[0];
    bf16_t* op = O + qtok * D + h * 32 + 4 * fq;
    u32x2 w0, w1;
    w0.x = cvt_pk_bf16(o0[0] * inv, o0[1] * inv); w0.y = cvt_pk_bf16(o0[2] * inv, o0[3] * inv);
    w1.x = cvt_pk_bf16(o1[0] * inv, o1[1] * inv); w1.y = cvt_pk_bf16(o1[2] * inv, o1[3] * inv);
    *(u32x2*)op = w0; *(u32x2*)(op + 16) = w1;
}

__device__ __forceinline__ void attn_phase(const bf16_t* __restrict__ QK, const bf16_t* __restrict__ VT, const float* __restrict__ rpb, bf16_t* O, LAS unsigned char* lds, int grp, int gc, int gs, int tid, int wave, int lane) {
    const int ql = lane & 15, fq = lane >> 4;
    u32x4 kreg[8], vreg[8];
    const int nunits = 2 * (NH / gs);
#define AT_UNIT(u_, h_, rg_, b_, rlo_, nr_) const int h_ = gc + gs * ((u_) >> 1), rg_ = 2 * (grp & 1) + ((u_) & 1), b_ = grp >> 1; \
        const int rlo_ = min(max(8 * rg_ - 4, 0), 24), nr_ = min(max(8 * rg_ + 3, 0), 24) + 7 - rlo_ + 1;
#define AT_LOAD(u_) do { AT_UNIT(u_, h_, rg_, b_, rlo_, nr_) \
        const char* kb_ = (const char*)(QK + ((size_t)b_ * SEQ + (size_t)rlo_ * 64) * 4096 + 2048 + h_ * 32);            \
        _Pragma("unroll") for (int q = 0; q < 8; ++q) { if (tid + q * (NWAVES * 64) < nr_ * 256) kreg[q] = *(const u32x4*)(kb_ + (size_t)q * (128u * 8192u) + kvo); } \
        const char* vb_ = (const char*)(VT + (size_t)h_ * 32 * NTOK + (size_t)b_ * SEQ + (size_t)rlo_ * 64); \
        _Pragma("unroll") for (int q = 0; q < 8; ++q) { if ((tid & 15) + 16 * q < nr_ * 8) vreg[q] = *(const u32x4*)(vb_ + vvo + q * 256); } } while (0)
    const unsigned kvo = (unsigned)(tid >> 2) * 8192u + (unsigned)(tid & 3) * 16u;
    const unsigned vvo = (unsigned)(tid >> 4) * (unsigned)(NTOK * 2) + (unsigned)(tid & 15) * 16u;
    int u = 0, h_prev = -1;
    if (u < nunits) AT_LOAD(u);
    for (; u < nunits; ++u) {
        AT_UNIT(u, h, rg, b, r_lo, nrows)
        const size_t tok0 = (size_t)b * SEQ;
#pragma unroll
        for (int q = 0; q < 8; ++q) { const int idx = tid + q * (NWAVES * 64);
            if (idx < nrows * 256) { const int it = idx >> 2, ch = idx & 3, tt = it & 63; *(LAS u32x4*)(lds + AT_K + it * 64 + ((ch ^ ((tt >> 3) & 3)) * 16)) = kreg[q]; } }
#pragma unroll
        for (int q = 0; q < 8; ++q) { const int ic = (tid & 15) + 16 * q, d = tid >> 4;
            if (ic < nrows * 8) *(LAS u32x4*)(lds + AT_V + ((ic >> 3) * 32 + d) * 128 + (((ic & 7) ^ ((d >> 1) & 7)) * 16)) = vreg[q]; }
        if (h != h_prev) {
            for (int idx = tid; idx < 4 * 960; idx += NWAVES * 64) {
                const int c = idx / 960, rem = idx - c * 960, dr = rem >> 6, x = rem & 63, xi = x - 16 + c;
                *(LAS float*)(lds + AT_B + c * AT_BCOPY + rem * 4) = (xi >= 0 && xi < 31) ? rpb[(h * 15 + dr) * 31 + xi] * LOG2E : 0.f;
            }
            h_prev = h;
        }
        __syncthreads();
        {
            const int r = 8 * rg + wave, r_start = min(max(r - 4, 0), 24), il0 = r_start - r_lo;
            bf16x8 qf[4];
#pragma unroll
            for (int j = 0; j < 4; ++j) qf[j] = *(const bf16x8*)(QK + (tok0 + (size_t)r * 64 + 16 * j + ql) * 4096 + h * 32 + fq * 8);
            const int un = u + 1;
            if (un < nunits) AT_LOAD(un);
#pragma unroll 1
            for (int jj = 0; jj < 4; jj += 2) {
                attn_qblock(jj ? qf[2] : qf[0], O, lds, tok0, r, r_start, il0, jj, h, ql, fq);
                attn_qblock(jj ? qf[3] : qf[1], O, lds, tok0, r, r_start, il0, jj + 1, h, ql, fq);
            }
        }
        __syncthreads();
    }
#undef AT_UNIT
#undef AT_LOAD
}

#define XB_TMO      128
#define XB_XCNT(j)  (256  + 64 * (j))
#define XB_XSUB(j)  (1280 + 64 * (j))
#define XB_XGEN(j)  (2304 + 64 * (j))
#define XB_TOP      3328
#define XB_TOPGEN   3392
#define XCD_BAR_WORDS 3456
#define XB_SPIN_CAP (1u << 22)
__device__ __forceinline__ unsigned xb_ld(unsigned* p)              { return __hip_atomic_load(p, __ATOMIC_RELAXED, __HIP_MEMORY_SCOPE_AGENT); }
__device__ __forceinline__ unsigned xb_add(unsigned* p, unsigned v) { return __hip_atomic_fetch_add(p, v, __ATOMIC_RELAXED, __HIP_MEMORY_SCOPE_AGENT); }
__device__ __forceinline__ unsigned xb_xcc_id() { unsigned r; asm volatile("s_getreg_b32 %0, hwreg(20, 0, 4)" : "=s"(r)); return r & 0xFu; }
#define XB_SPIN(cond, bar) do { unsigned _sp = 0; while (cond) { __builtin_amdgcn_s_sleep(1); \
    if ((++_sp & 255u) == 0u) { if (xb_ld(&(bar)[XB_TMO])) break; if (_sp > XB_SPIN_CAP) { atomicAdd(&(bar)[XB_TMO], 1u); break; } } } } while (0)
struct XcdBarrier { unsigned* bar; unsigned x; volatile LAS unsigned* st; unsigned G; };
__device__ __forceinline__ void xcd_barrier_complete(unsigned* bar, unsigned x, unsigned G, unsigned& nloc, unsigned& nx) {
    unsigned sum, cnt, mine, sp = 0u;
    for (;;) {
        sum = 0u; cnt = 0u; mine = 0u;
#pragma unroll
        for (unsigned j = 0; j < 16; ++j) { const unsigned c = xb_ld(&bar[XB_XCNT(j)]); sum += c; cnt += (c > 0u) ? 1u : 0u; mine = (j == x) ? c : mine; }
        if (sum == G) break;
        __builtin_amdgcn_s_sleep(1);
        if ((++sp & 255u) == 0u) { if (xb_ld(&bar[XB_TMO])) break; if (sp > XB_SPIN_CAP) { atomicAdd(&bar[XB_TMO], 1u); break; } }
    }
    nloc = mine > 0u ? mine : 1u; nx = cnt > 0u ? cnt : 1u;
}
__device__ __forceinline__ void xcd_barrier(const XcdBarrier& b, bool tid0) {
    asm volatile("s_waitcnt vmcnt(0)" ::: "memory");
    __syncthreads();
    if (tid0) {
        unsigned* bar = b.bar;
        __builtin_amdgcn_s_waitcnt(0);
        unsigned nloc = b.st[0], nx = b.st[1];
        if (nloc == 0u) { xcd_barrier_complete(bar, b.x, b.G, nloc, nx); b.st[0] = nloc; b.st[1] = nx; }
        const unsigned old = xb_add(&bar[XB_XSUB(b.x)], 1u);
        const unsigned gen = old / nloc;
        if (old + 1u == (gen + 1u) * nloc) {
            __builtin_amdgcn_fence(__ATOMIC_RELEASE, "agent");
            asm volatile("s_waitcnt vmcnt(0)" ::: "memory");
            const unsigned og = xb_add(&bar[XB_TOP], 1u);
            const unsigned tg = og / nx;
            if (og + 1u == (tg + 1u) * nx) xb_add(&bar[XB_TOPGEN], 1u);
            else XB_SPIN(xb_ld(&bar[XB_TOPGEN]) == tg, bar);
            __builtin_amdgcn_fence(__ATOMIC_ACQUIRE, "agent");
            xb_add(&bar[XB_XGEN(b.x)], 1u);
            asm volatile("s_waitcnt vmcnt(0)" ::: "memory");
        } else {
            XB_SPIN(xb_ld(&bar[XB_XGEN(b.x)]) == gen, bar);
            __builtin_amdgcn_fence(__ATOMIC_ACQUIRE, "agent");
            asm volatile("s_waitcnt vmcnt(0)" ::: "memory");
        }
    }
    __syncthreads();
}

struct EpiPleFinal {
    pg8::EpiPle base; const float* gfin; float* out; XcdBarrier bar; int wave_s;
    __device__ __forceinline__ void operator()(pg8::Acc& acc, const pg8::Unit& u, int wr, int wc, int fr, int fq) const {
        base(acc, u, wr, wc, fr, fq);
        xcd_barrier(bar, tid_now(wave_s) == 0);
        const int row0 = u.pm * pg8::BM + wr * 64 + fr, col0 = u.pn * pg8::BM + wc * 32 + 8 * fq;
        f32x4 gv[2][2];
#pragma unroll
        for (int bj = 0; bj < 2; ++bj)
#pragma unroll
            for (int n = 0; n < 2; ++n) gv[bj][n] = *(const f32x4*)(gfin + col0 + bj * pg8::HALF + 4 * n);
        pg8::ssq_t sv[8];
#pragma unroll
        for (int q = 0; q < 8; ++q) sv[q] = base.ssq_out[row0 + (q >> 2) * pg8::HALF + (q & 3) * 16];
#pragma unroll
        for (int ai = 0; ai < 2; ++ai)
#pragma unroll
            for (int m = 0; m < 4; ++m) {
                const float rr = pg8::rms_r(sv[ai * 4 + m]);
                float* op = out + (size_t)(row0 + ai * pg8::HALF + m * 16) * D + col0;
#pragma unroll
                for (int bj = 0; bj < 2; ++bj) {
                    *(f32x4*)(op + bj * pg8::HALF) = acc[ai][bj][m][0] * rr * gv[bj][0];
                    *(f32x4*)(op + bj * pg8::HALF + 4) = acc[ai][bj][m][1] * rr * gv[bj][1];
                }
            }
    }
};

struct Args { const float* in[19]; float* out; unsigned char* ws; };

typedef const __attribute__((address_space(4))) Args* ArgsP;
__device__ __forceinline__ ArgsP get_args() { ArgsP p = (ArgsP)__builtin_amdgcn_kernarg_segment_ptr(); asm volatile("" : "+s"(p)); return p; }
#define WSP(off) ((bf16_t*)(A->ws + (off)))

__global__ void __launch_bounds__(NWAVES * 64, 2) fwd_megakernel(Args args_unused) {
    extern __shared__ __attribute__((aligned(16))) unsigned char lds_raw[];
    LAS unsigned char* lds = (LAS unsigned char*)lds_raw;
    cg::grid_group grid = cg::this_grid();
    const int G = gridDim.x;
    const int wave_s = __builtin_amdgcn_readfirstlane((int)threadIdx.x >> 6);
    volatile LAS unsigned* bar_st = (volatile LAS unsigned*)(lds + LDS_BYTES - 32);
    if (threadIdx.x == 0) { for (int q = 0; q < 8; ++q) bar_st[q] = 0u; }
    __syncthreads();
    { ArgsP A = get_args(); if (tid_now(wave_s) == 0) { unsigned* bw = (unsigned*)(A->ws + WS_BAR); const unsigned xc = xb_xcc_id(); const int g_ = blk_now() & 7;
        (void)xb_add(bw + 4096 * g_ + XB_XCNT(xc), 1u); (void)xb_add(bw + 4096 * (8 + (g_ >> 1)) + XB_XCNT(xc), 1u); (void)xb_add(bw + 4096 * 12 + XB_XCNT(xc), 1u); } }
#define IDS() const int tid_ = tid_now(wave_s); const int lane = tid_ & 63, wave = wave_s; \
    const int gw = blockIdx.x * NWAVES + wave, NGW = gridDim.x * NWAVES, gtid = blockIdx.x * (NWAVES * 64) + tid_, nthr = gridDim.x * NWAVES * 64; (void)lane; (void)gw; (void)NGW; (void)gtid; (void)nthr;

    {
        ArgsP A = get_args(); IDS();
        LAS float* scr = (LAS float*)(lds + wave * 16384);
        int rot = 0;
#pragma unroll 1
        for (int j = 0; j < 2; ++j) {
            const float* wq = A->in[3] + (size_t)j * D * 3 * D; const float* ga = A->in[2] + j * D;
            conv_mat(wq, D, 3 * D, WSP(WS_WQK) + (size_t)j * 4096 * D, 0, 0, 0, 2048, nullptr, ga, QSCALE, 1, scr, rot, gw, NGW, lane);
            conv_mat(wq, D, 3 * D, WSP(WS_WQK) + (size_t)j * 4096 * D, 0, 2048, 2048, 4096, nullptr, ga, 1.f, 1, scr, rot, gw, NGW, lane);
            conv_mat(wq, D, 3 * D, WSP(WS_WV) + (size_t)j * D * D, 0, 0, 4096, 6144, nullptr, ga, 1.f, 1, scr, rot, gw, NGW, lane);
            conv_mat(A->in[5] + (size_t)j * D * D, D, D, WSP(WS_WO) + (size_t)j * D * D, 0, 0, 0, D, nullptr, nullptr, 1.f, 0, scr, rot, gw, NGW, lane);
#pragma unroll 1
            for (int gI = 0; gI < 4; ++gI)
                conv_mat(A->in[8] + ((size_t)j * 4 + gI) * 512 * 512, 512, 512, WSP(WS_WPOOL) + (size_t)j * D * 512, 0, gI * 512, 0, 512, A->in[9] + j * D + gI * 512, nullptr, 1.f, 0, scr, rot, gw, NGW, lane);
        }
#pragma unroll 1
        for (int i = 0; i < DEPTH; ++i) {
            bf16_t* wgu_t = WSP(WS_WGU) + (size_t)i * 2 * DFF * D;
            if (i == 0) conv_mat(A->in[11] + (size_t)i * D * DFF, D, DFF, wgu_t, 1, 0, 0, DFF, nullptr, A->in[10] + i * D, 1.f, 1, scr, rot, gw, NGW, lane);
            conv_mat(A->in[12] + (size_t)i * D * DFF, D, DFF, wgu_t, 2, 0, 0, DFF, nullptr, A->in[10] + i * D, 1.f, 1, scr, rot, gw, NGW, lane);
            if (i == 0) {
                conv_mat(A->in[13] + (size_t)i * DFF * D, DFF, D, WSP(WS_WD) + (size_t)i * D * DFF, 0, 0, 0, D, nullptr, nullptr, 1.f, 0, scr, rot, gw, NGW, lane);
                conv_mat(A->in[15] + (size_t)i * D * D, D, D, WSP(WS_WPG) + (size_t)i * D * D, 0, 0, 0, D, nullptr, A->in[14] + i * D, 1.f, 1, scr, rot, gw, NGW, lane);
            }
            conv_mat(A->in[17] + (size_t)i * PLE * D, PLE, D, WSP(WS_WPP) + (size_t)i * D * PLE, 0, 0, 0, D, nullptr, nullptr, 1.f, 0, scr, rot, gw, NGW, lane);
        }
        const f32x4* p4 = (const f32x4*)A->in[1]; u32x2* pb = (u32x2*)WSP(WS_PB);
        for (int idx = gtid; idx < DEPTH * NTOK * PLE / 4; idx += nthr) {
            const f32x4 v = p4[idx]; u32x2 w; w.x = cvt_pk_bf16(v.x, v.y); w.y = cvt_pk_bf16(v.z, v.w); pb[idx] = w;
        }
        pg8::ssq_t* ssq = (pg8::ssq_t*)(A->ws + WS_SSQ);
        for (int idx = gtid; idx < 12 * NTOK; idx += nthr) ssq[NTOK + idx] = 0u;
        xb_ssq_phase(A->in[0], WSP(WS_H), ssq, gw, NGW, lane);
    }
    { ArgsP A_ = get_args(); XcdBarrier b_; b_.bar = (unsigned*)(A_->ws + WS_BAR) + 4096 * 12; b_.x = xb_xcc_id(); b_.st = bar_st + 6; b_.G = (unsigned)G; xcd_barrier(b_, tid_now(wave_s) == 0); }
    if (get_args()->ws == nullptr) grid.sync();

#define SSQ(n) ((pg8::ssq_t*)(A->ws + WS_SSQ) + (size_t)(n) * NTOK)
#define XBCUR WSP((i & 1) ? WS_H2 : WS_H)
#define XBNXT WSP((i & 1) ? WS_H : WS_H2)
#define GRP (blk_now() & 7)
#define GC (blk_now() >> 3)
    const int GS = G >> 3;
#define GROUP_BAR() do { ArgsP A_ = get_args(); XcdBarrier b_; b_.bar = (unsigned*)(A_->ws + WS_BAR) + 4096 * GRP; b_.x = xb_xcc_id(); b_.st = bar_st; b_.G = (unsigned)GS; xcd_barrier(b_, tid_now(wave_s) == 0); } while (0)
#define PAIR_BAR() do { ArgsP A_ = get_args(); XcdBarrier b_; b_.bar = (unsigned*)(A_->ws + WS_BAR) + 4096 * (8 + (GRP >> 1)); b_.x = xb_xcc_id(); b_.st = bar_st + 2; b_.G = (unsigned)(2 * GS); xcd_barrier(b_, tid_now(wave_s) == 0); } while (0)
#define CONV_WORD(n) ((unsigned*)(A_->ws + WS_BAR) + 13 * 4096 + 64 * (n))
#define CONV_DONE(n) do { ArgsP A_ = get_args(); if (tid_now(wave_s) == 0) (void)xb_add(CONV_WORD(n), 1u); } while (0)
#define CONV_WAIT(n) do { ArgsP A_ = get_args(); if (tid_now(wave_s) == 0) { unsigned sp_ = 0u; while (xb_ld(CONV_WORD(n)) < (unsigned)(G / 2)) { __builtin_amdgcn_s_sleep(1); if (++sp_ > XB_SPIN_CAP) break; } \
        __builtin_amdgcn_fence(__ATOMIC_ACQUIRE, "agent"); asm volatile("s_waitcnt vmcnt(0)" ::: "memory"); } __syncthreads(); } while (0)
#define GIDS() IDS(); const int lgtid = GC * (NWAVES * 64) + tid_, lnthr = GS * (NWAVES * 64); (void)lgtid; (void)lnthr;
#pragma unroll 1
    for (int i = 0; i < DEPTH; ++i) {
        const int j = i >> 1;
        if ((i & 1) == 0) {
            {
                ArgsP A = get_args();
                pg8::GroupOrder S; S.init(0, 4096 / 256, GS, GC, GRP);
                pg8::Gemm g{XBCUR, WSP(WS_WQK) + (size_t)j * 4096 * D, NTOK, 4096, D, D, 0, 0};
                pg8::EpiBf16 E{WSP(WS_QK), 4096, A->in[4] + j * 3 * D, SSQ(3 * i), 8, QSCALE};
                pg8::gemm_phase<true>(lds, g, S, E, wave_s);
            }
            {
                ArgsP A = get_args();
                pg8::GroupOrder S; S.init(1, D / 256, GS, GC, GRP);
                pg8::Gemm g{WSP(WS_WV) + (size_t)j * D * D, XBCUR, D, NTOK, D, D, 0, 0};
                pg8::EpiVT E{WSP(WS_VT), A->in[4] + j * 3 * D + 4096, SSQ(3 * i)};
                pg8::gemm_phase<true>(lds, g, S, E, wave_s);
            }
            PAIR_BAR();
            { ArgsP A = get_args(); IDS(); attn_phase(WSP(WS_QK), WSP(WS_VT), A->in[6] + (size_t)j * NH * 15 * 31, WSP(WS_O), lds, GRP, GC, GS, tid_, wave, lane); }
            GROUP_BAR();
            {
                ArgsP A = get_args();
                pg8::GroupOrder S; S.init(0, D / 256, GS, GC, GRP);
                pg8::Gemm g{WSP(WS_O), WSP(WS_WO) + (size_t)j * D * D, NTOK, D, D, D, 0, 0};
                pg8::EpiResid E{XBCUR, SSQ(3 * i + 1)};
                pg8::gemm_phase<false>(lds, g, S, E, wave_s);
            }
            GROUP_BAR();
        } else {
            { ArgsP A = get_args(); GIDS(); poolmix_phase(XBCUR, SSQ(3 * i), A->in[7] + j * D, WSP(WS_O), 1024 * GRP, 1024, lgtid, lnthr, lds, tid_); }
            PAIR_BAR();
            {
                ArgsP A = get_args();
                pg8::GroupOrder S; S.init(0, D / 256, GS, GC, GRP);
                pg8::Gemm g{WSP(WS_O), WSP(WS_WPOOL) + (size_t)j * D * 512, NTOK, D, 512, D, 1, 512};
                pg8::EpiResid E{XBCUR, SSQ(3 * i + 1)};
                pg8::gemm_phase<false>(lds, g, S, E, wave_s);
            }
            GROUP_BAR();
        }
        if (i > 0) CONV_WAIT(i);
        {
            ArgsP A = get_args(); IDS();
            const pg8::ssq_t* sq = SSQ(3 * i + 1) + 256 * (4 * GRP + (GC & 3));
            if (tid_ < 256) ((LAS float*)(lds + 131072))[tid_] = pg8::rms_r(sq[tid_]);
            __syncthreads();
        }
        {
            ArgsP A = get_args();
            pg8::GroupOrder S; S.init(0, 2 * DFF / 256, GS, GC, GRP);
            pg8::Gemm g{XBCUR, WSP(WS_WGU) + (size_t)i * 2 * DFF * D, NTOK, 2 * DFF, D, D, 0, 0};
            pg8::EpiGU E{WSP(WS_ACT), (const LAS float*)(lds + 131072)};
            pg8::gemm_phase<true>(lds, g, S, E, wave_s);
        }
        {
            ArgsP A = get_args();
            pg8::GroupOrder S; S.init(0, D / 256, GS / 2, GC - GS / 2, GRP);
            pg8::Gemm g{WSP(WS_PB) + (size_t)i * NTOK * PLE, WSP(WS_WPP) + (size_t)i * D * PLE, NTOK, D, PLE, PLE, 0, 0};
            pg8::EpiBf16 E{WSP(WS_PP), D, nullptr, nullptr, 0, 1.f};
            pg8::gemm_phase<false>(lds, g, S, E, wave_s);
        }
        if (i + 1 < DEPTH && GC >= GS / 2) {
            ArgsP A = get_args(); IDS();
            LAS float* scr = (LAS float*)(lds + wave * 16384);
            int rot = 0;
            const int hgw = ((GC - GS / 2) * 8 + GRP) * NWAVES + wave, hNGW = (G / 2) * NWAVES, n = i + 1;
            conv_mat(A->in[13] + (size_t)n * DFF * D, DFF, D, WSP(WS_WD) + (size_t)n * D * DFF, 0, 0, 0, D, nullptr, nullptr, 1.f, 0, scr, rot, hgw, hNGW, lane);
            conv_mat(A->in[15] + (size_t)n * D * D, D, D, WSP(WS_WPG) + (size_t)n * D * D, 0, 0, 0, D, nullptr, A->in[14] + n * D, 1.f, 1, scr, rot, hgw, hNGW, lane);
            conv_mat(A->in[11] + (size_t)n * D * DFF, D, DFF, WSP(WS_WGU) + (size_t)n * 2 * DFF * D, 1, 0, 0, DFF, nullptr, A->in[10] + n * D, 1.f, 1, scr, rot, hgw, hNGW, lane);
        }
        GROUP_BAR();
        if (i + 1 < DEPTH && GC >= GS / 2) CONV_DONE(i + 1);
        if (i > 0) CONV_WAIT(i);
        {
            ArgsP A = get_args();
            pg8::GroupOrder S; S.init(0, D / 256, GS, GC, GRP);
            pg8::Gemm g{WSP(WS_ACT), WSP(WS_WD) + (size_t)i * D * DFF, NTOK, D, DFF, DFF, 0, 0};
            pg8::EpiResid E{XBCUR, SSQ(3 * i + 2)};
            pg8::gemm_phase<false>(lds, g, S, E, wave_s);
        }
        GROUP_BAR();
        if (i < DEPTH - 1) {
            {
                ArgsP A = get_args();
                pg8::GroupOrder S; S.init(0, D / 256, GS, GC, GRP);
                pg8::Gemm g{XBCUR, WSP(WS_WPG) + (size_t)i * D * D, NTOK, D, D, D, 0, 0};
                pg8::EpiPle E{XBCUR, XBNXT, WSP(WS_PP), A->in[16] + i * D, SSQ(3 * i + 2), SSQ(3 * i + 3)};
                pg8::gemm_phase<true>(lds, g, S, E, wave_s);
            }
            if ((i & 1) == 0) PAIR_BAR(); else GROUP_BAR();
        } else {
            ArgsP A = get_args();
            pg8::GroupOrder S; S.init(0, D / 256, GS, GC, GRP);
            pg8::Gemm g{XBCUR, WSP(WS_WPG) + (size_t)i * D * D, NTOK, D, D, D, 0, 0};
            XcdBarrier gb; gb.bar = (unsigned*)(A->ws + WS_BAR) + 4096 * GRP; gb.x = xb_xcc_id(); gb.st = bar_st; gb.G = (unsigned)GS;
            EpiPleFinal E{pg8::EpiPle{XBCUR, nullptr, WSP(WS_PP), A->in[16] + i * D, SSQ(3 * i + 2), SSQ(3 * i + 3)}, A->in[18], A->out, gb, wave_s};
            pg8::gemm_phase<true>(lds, g, S, E, wave_s);
        }
    }
}

extern "C" void kernel_launch(void* const* d_in, const int* in_sizes, int n_in, void* d_out, int out_size, void* d_ws, size_t ws_size, hipStream_t stream) {
    static int grid = 0;
    if (grid == 0) {
        if (n_in != 19 || out_size != NTOK * D || ws_size < WS_END) { fprintf(stderr, "kernel_launch: unexpected shapes (n_in %d, out %d, ws %zu < %zu)\n", n_in, out_size, ws_size, (size_t)WS_END); grid = -1; return; }
        int dev = 0, cus = 0, per_cu = 0;
        hipGetDevice(&dev);
        hipDeviceGetAttribute(&cus, hipDeviceAttributeMultiprocessorCount, dev);
        if (hipFuncSetAttribute((const void*)fwd_megakernel, hipFuncAttributeMaxDynamicSharedMemorySize, LDS_BYTES) != hipSuccess) { fprintf(stderr, "kernel_launch: hipFuncSetAttribute failed\n"); grid = -1; return; }
        if (hipOccupancyMaxActiveBlocksPerMultiprocessor(&per_cu, (const void*)fwd_megakernel, NWAVES * 64, LDS_BYTES) != hipSuccess || per_cu < 1) { fprintf(stderr, "kernel_launch: occupancy query failed (%d)\n", per_cu); (void)hipGetLastError(); per_cu = 1; }
        grid = cus * per_cu;
        if (grid % 8 != 0 || ((grid / 8) & (grid / 8 - 1)) != 0 || NH % (grid / 8) != 0 || (NTOK / 256) % 8 != 0) { fprintf(stderr, "kernel_launch: grid %d is not a multiple of 8\n", grid); grid = -1; return; }
    }
    if (grid < 0) return;
    Args a{};
    for (int i = 0; i < 19; ++i) a.in[i] = (const float*)d_in[i];
    a.out = (float*)d_out; a.ws = (unsigned char*)d_ws;
    if (hipMemsetAsync((unsigned char*)d_ws + WS_BAR, 0, (size_t)(13 * 4096 + 8 * 64) * 4, stream) != hipSuccess) { fprintf(stderr, "kernel_launch: hipMemsetAsync of the barrier words failed\n"); return; }
    void* kargs[] = {&a};
    hipError_t e = hipLaunchCooperativeKernel((const void*)fwd_megakernel, dim3(grid), dim3(NWAVES * 64), kargs, LDS_BYTES, stream);
    if (e != hipSuccess) fprintf(stderr, "cooperative launch failed: %s (grid %d)\n", hipGetErrorString(e), grid);
}
```
